# Optimizing an MI355X kernel written in HIP

```python
import jax, jax.numpy as jnp
from jax import lax
import numpy as np

D_MODEL = 1024
BATCH = 32
SEQ = 2048
DEPTH = 2
DEC_BATCH = 4
DEC_SEQ = 4096
PAST_LEN = 128

N_META = 16
BLOCK = 128
WINDOW = 128
ROPE_THETA = 500000.0
MLA_HEADS = D_MODEL // 64
MLA_NOPE = 64
MLA_ROPE = 32
MLA_V = 64
MLA_KV_RANK = 4 * MLA_NOPE
MLA_Q_RANK = 3 * MLA_KV_RANK
GQA_Q_HEADS = 16
GQA_KV_HEADS = 4
GQA_GROUP = GQA_Q_HEADS // GQA_KV_HEADS
GQA_HEAD_DIM = D_MODEL // GQA_Q_HEADS
GQA_ROT = GQA_HEAD_DIM // 4
D_FF = 4 * D_MODEL
N_MLA_LAYERS = (DEPTH + 1) // 2
N_GQA_LAYERS = DEPTH // 2
DN_ALPHA = (2.0 * DEPTH) ** 0.25
DN_BETA = (8.0 * DEPTH) ** -0.25
LN_EPS = 1e-5
RMS_EPS = 1e-6
NEG_INF = -1e30

kernel_name = 'hybrid_mla_swa_sink_encoder'


def layer_norm(x, g, b):
    xf = x.astype(jnp.float32)
    mu = jnp.mean(xf, axis=-1, keepdims=True)
    xc = xf - mu
    var = jnp.mean(xc * xc, axis=-1, keepdims=True)
    y = xc * lax.rsqrt(var + LN_EPS) * g.astype(jnp.float32) + b.astype(jnp.float32)
    return y.astype(x.dtype)


def rms_norm(x, g):
    xf = x.astype(jnp.float32)
    y = xf * lax.rsqrt(jnp.mean(xf * xf, axis=-1, keepdims=True) + RMS_EPS) * g.astype(jnp.float32)
    return y.astype(x.dtype)


def rope_tables(length, dim, dtype):
    pos = jnp.arange(length, dtype=jnp.float32)
    inv = ROPE_THETA ** (-jnp.arange(0, dim, 2, dtype=jnp.float32) / dim)
    ang = pos[:, None] * inv[None, :]
    return jnp.cos(ang).astype(dtype), jnp.sin(ang).astype(dtype)


def apply_rope(x, cos, sin):
    c = cos[None, :, None, :]
    s = sin[None, :, None, :]
    x1, x2 = jnp.split(x, 2, axis=-1)
    return jnp.concatenate([x1 * c - x2 * s, x2 * c + x1 * s], axis=-1)


def partial_rope(x, cos, sin):
    return jnp.concatenate([apply_rope(x[..., :GQA_ROT], cos, sin), x[..., GQA_ROT:]], axis=-1)


def mla_attend(qn, qr, kn, kr, v):
    scale = (MLA_NOPE + MLA_ROPE) ** -0.5
    s = jnp.einsum('bqhd,bkhd->bhqk', qn, kn) + jnp.einsum('bqhr,bkr->bhqk', qr, kr)
    p = jax.nn.softmax(s.astype(jnp.float32) * scale, axis=-1).astype(v.dtype)
    return jnp.einsum('bhqk,bkhd->bqhd', p, v)


def mla_mixer(x, cos, sin, w_in, g_q, w_uq, g_kv, w_ukv, w_o):
    B, L, _ = x.shape
    S = L - N_META
    nb = S // BLOCK
    c = x @ w_in
    cq = rms_norm(c[..., :MLA_Q_RANK], g_q)
    ckv = rms_norm(c[..., MLA_Q_RANK:MLA_Q_RANK + MLA_KV_RANK], g_kv)
    kr = apply_rope(c[..., MLA_Q_RANK + MLA_KV_RANK:][:, :, None, :], cos, sin)[:, :, 0, :]
    q = (cq @ w_uq).reshape(B, L, MLA_HEADS, MLA_NOPE + MLA_ROPE)
    qn = q[..., :MLA_NOPE]
    qr = apply_rope(q[..., MLA_NOPE:], cos, sin)
    kv = (ckv @ w_ukv).reshape(B, L, MLA_HEADS, MLA_NOPE + MLA_V)
    kn = kv[..., :MLA_NOPE]
    v = kv[..., MLA_NOPE:]
    out_meta = mla_attend(qn[:, :N_META], qr[:, :N_META], kn, kr, v)

    def to_blocks(t):
        return t[:, N_META:].reshape((B, nb, BLOCK) + t.shape[2:]).swapaxes(0, 1)

    out_real = lax.map(lambda qb: mla_attend(qb[0], qb[1], kn, kr, v), (to_blocks(qn), to_blocks(qr)))
    out_real = out_real.swapaxes(0, 1).reshape(B, S, MLA_HEADS, MLA_V)
    out = jnp.concatenate([out_meta, out_real], axis=1).reshape(B, L, MLA_HEADS * MLA_V)
    return out @ w_o


def sink_attend(q, k, v, mask, sink):
    s = jnp.einsum('bqkgd,bjkd->bkgqj', q, k).astype(jnp.float32) * (GQA_HEAD_DIM ** -0.5)
    s = jnp.where(mask, s, NEG_INF)
    sk = sink.astype(jnp.float32)[None, :, :, None, None]
    m = jnp.maximum(jnp.max(s, axis=-1, keepdims=True), sk)
    p = jnp.exp(s - m)
    denom = jnp.sum(p, axis=-1, keepdims=True) + jnp.exp(sk - m)
    p = (p / denom).astype(v.dtype)
    return jnp.einsum('bkgqj,bjkd->bqkgd', p, v)


def gqa_mixer(x, cos, sin, w_qkv, sink, w_o):
    B, L, _ = x.shape
    S = L - N_META
    nb = S // BLOCK
    qd = GQA_Q_HEADS * GQA_HEAD_DIM
    kd = GQA_KV_HEADS * GQA_HEAD_DIM
    qkv = x @ w_qkv
    q = partial_rope(qkv[..., :qd].reshape(B, L, GQA_Q_HEADS, GQA_HEAD_DIM), cos, sin)
    k = partial_rope(qkv[..., qd:qd + kd].reshape(B, L, GQA_KV_HEADS, GQA_HEAD_DIM), cos, sin)
    v = qkv[..., qd + kd:].reshape(B, L, GQA_KV_HEADS, GQA_HEAD_DIM)
    q = q.reshape(B, L, GQA_KV_HEADS, GQA_GROUP, GQA_HEAD_DIM)
    sink = sink.reshape(GQA_KV_HEADS, GQA_GROUP)
    km, vm = k[:, :N_META], v[:, :N_META]
    kr, vr = k[:, N_META:], v[:, N_META:]
    nk = N_META + WINDOW
    meta_mask = jnp.arange(nk)[None, :] <= jnp.arange(N_META)[:, None] + WINDOW
    out_meta = sink_attend(q[:, :N_META], k[:, :nk], v[:, :nk], meta_mask, sink)
    kr_pad = jnp.pad(kr, ((0, 0), (BLOCK, BLOCK), (0, 0), (0, 0)))
    vr_pad = jnp.pad(vr, ((0, 0), (BLOCK, BLOCK), (0, 0), (0, 0)))
    span = 3 * BLOCK
    qi = jnp.arange(BLOCK)[:, None]
    kj = jnp.arange(span)[None, :]
    meta_vis = jnp.ones((BLOCK, N_META), dtype=bool)

    def block_fn(args):
        b, qb = args
        kb = lax.dynamic_slice_in_dim(kr_pad, b * BLOCK, span, axis=1)
        vb = lax.dynamic_slice_in_dim(vr_pad, b * BLOCK, span, axis=1)
        rk = b * BLOCK - BLOCK + kj
        band = (jnp.abs(qi + BLOCK - kj) <= WINDOW) & (rk >= 0) & (rk < S)
        mask = jnp.concatenate([meta_vis, band], axis=1)
        return sink_attend(qb, jnp.concatenate([km, kb], axis=1), jnp.concatenate([vm, vb], axis=1), mask, sink)

    q_blocks = q[:, N_META:].reshape(B, nb, BLOCK, GQA_KV_HEADS, GQA_GROUP, GQA_HEAD_DIM).swapaxes(0, 1)
    out_real = lax.map(block_fn, (jnp.arange(nb), q_blocks)).swapaxes(0, 1).reshape(B, S, qd)
    out = jnp.concatenate([out_meta.reshape(B, N_META, qd), out_real], axis=1)
    return out @ w_o


def sqrelu_mlp(x, w1, w2):
    h = jax.nn.relu(x @ w1)
    return (h * h) @ w2


def trunk(x, meta_tokens, mla_w_in, mla_g_q, mla_w_uq, mla_g_kv, mla_w_ukv, mla_w_o,
          gqa_w_qkv, gqa_sink, gqa_w_o, mlp_w1, mlp_w2, ln1_g, ln1_b, ln2_g, ln2_b):
    B, S, D = x.shape
    meta = jnp.broadcast_to(meta_tokens[None].astype(x.dtype), (B, N_META, D))
    h = jnp.concatenate([meta, x], axis=1)
    L = S + N_META
    cos_a, sin_a = rope_tables(L, MLA_ROPE, x.dtype)
    cos_b, sin_b = rope_tables(L, GQA_ROT, x.dtype)
    for i in range(DEPTH):
        j = i // 2
        if i % 2 == 0:
            mix = mla_mixer(h, cos_a, sin_a, mla_w_in[j], mla_g_q[j], mla_w_uq[j],
                            mla_g_kv[j], mla_w_ukv[j], mla_w_o[j])
        else:
            mix = gqa_mixer(h, cos_b, sin_b, gqa_w_qkv[j], gqa_sink[j], gqa_w_o[j])
        h = layer_norm(DN_ALPHA * h + mix, ln1_g[i], ln1_b[i])
        h = layer_norm(DN_ALPHA * h + sqrelu_mlp(h, mlp_w1[i], mlp_w2[i]), ln2_g[i], ln2_b[i])
    return h[:, N_META:]


def setup_inputs(seed: int = 0) -> dict:
    key = jax.random.key(seed)
    ks = jax.random.split(key, 20)

    def nrm(k, shape, scale):
        return jax.random.normal(k, shape, jnp.float32) * scale

    d = D_MODEL
    a, g = N_MLA_LAYERS, N_GQA_LAYERS
    qkv_out = (GQA_Q_HEADS + 2 * GQA_KV_HEADS) * GQA_HEAD_DIM
    return {
        'x_prompt': nrm(ks[0], (BATCH, SEQ, d), 1.0),
        'x_sample': nrm(ks[1], (DEC_BATCH, DEC_SEQ, d), 1.0),
        'meta_tokens': nrm(ks[2], (N_META, d), 1.0),
        'mla_w_in': nrm(ks[3], (a, d, MLA_Q_RANK + MLA_KV_RANK + MLA_ROPE), d ** -0.5),
        'mla_g_q': 1.0 + nrm(ks[4], (a, MLA_Q_RANK), 0.02),
        'mla_w_uq': nrm(ks[5], (a, MLA_Q_RANK, MLA_HEADS * (MLA_NOPE + MLA_ROPE)), MLA_Q_RANK ** -0.5),
        'mla_g_kv': 1.0 + nrm(ks[6], (a, MLA_KV_RANK), 0.02),
        'mla_w_ukv': nrm(ks[7], (a, MLA_KV_RANK, MLA_HEADS * (MLA_NOPE + MLA_V)), MLA_KV_RANK ** -0.5),
        'mla_w_o': nrm(ks[8], (a, MLA_HEADS * MLA_V, d), DN_BETA * (MLA_HEADS * MLA_V) ** -0.5),
        'gqa_w_qkv': nrm(ks[9], (g, d, qkv_out), d ** -0.5),
        'gqa_sink': nrm(ks[10], (g, GQA_Q_HEADS), 0.5),
        'gqa_w_o': nrm(ks[11], (g, GQA_Q_HEADS * GQA_HEAD_DIM, d), DN_BETA * (GQA_Q_HEADS * GQA_HEAD_DIM) ** -0.5),
        'mlp_w1': nrm(ks[12], (DEPTH, d, D_FF), d ** -0.5),
        'mlp_w2': nrm(ks[13], (DEPTH, D_FF, d), DN_BETA * D_FF ** -0.5),
        'ln1_g': 1.0 + nrm(ks[14], (DEPTH, d), 0.02),
        'ln1_b': nrm(ks[15], (DEPTH, d), 0.02),
        'ln2_g': 1.0 + nrm(ks[16], (DEPTH, d), 0.02),
        'ln2_b': nrm(ks[17], (DEPTH, d), 0.02),
    }


def reference(x_prompt, x_sample, meta_tokens, mla_w_in, mla_g_q, mla_w_uq, mla_g_kv, mla_w_ukv, mla_w_o,
              gqa_w_qkv, gqa_sink, gqa_w_o, mlp_w1, mlp_w2, ln1_g, ln1_b, ln2_g, ln2_b):
    y_prompt = trunk(x_prompt, meta_tokens, mla_w_in, mla_g_q, mla_w_uq, mla_g_kv, mla_w_ukv, mla_w_o,
                     gqa_w_qkv, gqa_sink, gqa_w_o, mlp_w1, mlp_w2, ln1_g, ln1_b, ln2_g, ln2_b)
    y_sample = trunk(x_sample, meta_tokens, mla_w_in, mla_g_q, mla_w_uq, mla_g_kv, mla_w_ukv, mla_w_o,
                     gqa_w_qkv, gqa_sink, gqa_w_o, mlp_w1, mlp_w2, ln1_g, ln1_b, ln2_g, ln2_b)
    return (y_prompt, y_sample)
```

```cpp
#include <hip/hip_runtime.h>
#include <hip/hip_cooperative_groups.h>
#include <cstdio>
#include <cstdint>
#include <cmath>
namespace cg = cooperative_groups;

#ifndef MK_PER_PHASE
#define MK_PER_PHASE 0
#endif

#define LAS __attribute__((address_space(3)))
typedef unsigned short bf16_t;
typedef short bf16x8 __attribute__((ext_vector_type(8)));
typedef float f32x4 __attribute__((ext_vector_type(4)));
typedef float f32x16 __attribute__((ext_vector_type(16)));
typedef unsigned u32x4 __attribute__((ext_vector_type(4)));
typedef unsigned u32x2 __attribute__((ext_vector_type(2)));

constexpr int DM = 1024, NMETA = 16;
constexpr int NSEQ_P = 32, L_P = 2048 + NMETA, NSEQ_S = 4, L_S = 4096 + NMETA;
constexpr int T_P = NSEQ_P * L_P;
constexpr int T_ALL = T_P + NSEQ_S * L_S;
constexpr int TP = 82688;
constexpr int LPAD_P = 2112, LPAD_S = 4160;
constexpr int NC = 1056;
constexpr int DFF = 4096;
constexpr float LN_EPS = 1e-5f, RMS_EPS = 1e-6f;
constexpr float DN_ALPHA = 1.4142135623730951f;
constexpr float LOG2E = 1.4426950408889634f;
constexpr float C2_MLA = 0.10206207261596575f * LOG2E;
constexpr float C2_GQA = 0.125f * LOG2E;

constexpr size_t MiB = 1u << 20;
constexpr size_t WS_ROPEA = 1 * MiB;
constexpr size_t WS_ROPEB = WS_ROPEA + 4112 * 32 * 4;
constexpr size_t WS_RS = WS_ROPEB + 4112 * 16 * 4;
constexpr size_t WS_W = 2 * MiB;
constexpr size_t W_IN = WS_W;
constexpr size_t W_UQ = W_IN + 1280 * 1024 * 2;
constexpr size_t W_UKV = W_UQ + 1536 * 768 * 2;
constexpr size_t W_O0 = W_UKV + 2048 * 256 * 2;
constexpr size_t W_QKV = W_O0 + 1024 * 1024 * 2;
constexpr size_t W_O1 = W_QKV + 1536 * 1024 * 2;
constexpr size_t W_1 = W_O1 + 1024 * 1024 * 2;
constexpr size_t W_2 = W_1 + 2 * (size_t)4096 * 1024 * 2;
constexpr size_t W_END = W_2 + 2 * (size_t)4096 * 1024 * 2;
constexpr size_t WS_X = 48 * MiB;
constexpr size_t WS_BIG = 371 * MiB;
constexpr size_t B_C = WS_BIG;
constexpr size_t B_ATT = WS_BIG;
constexpr size_t B_Q = WS_BIG + 168 * MiB;
constexpr size_t B_KN = WS_BIG + 411 * MiB;
constexpr size_t B_VT2 = WS_BIG + 372 * MiB;
constexpr size_t B_U = WS_BIG;
constexpr size_t WS_NEED = WS_BIG + 646 * MiB;
static_assert(W_END <= WS_X, "weights fit");
constexpr size_t O_H = 0;
constexpr size_t O_KR = 166 * MiB;
constexpr size_t VT_S_OFF16 = (size_t)NSEQ_P * 16 * 64 * LPAD_P;
constexpr size_t VT_S_OFF4 = (size_t)NSEQ_P * 4 * 64 * LPAD_P;

__device__ __forceinline__ unsigned cvt_pk_bf16(float lo, float hi) { unsigned r; asm volatile("v_cvt_pk_bf16_f32 %0, %1, %2" : "=v"(r) : "v"(lo), "v"(hi)); return r; }
__device__ __forceinline__ float bf2f(unsigned short b) { return __uint_as_float((unsigned)b << 16); }
__device__ __forceinline__ float wave_sum(float v) {
#pragma unroll
    for (int o = 1; o < 64; o <<= 1) v += __shfl_xor(v, o);
    return v;
}
__device__ __forceinline__ void tok2sp(int t, int& seq, int& pos) {
    if (t < T_P) { seq = t / L_P; pos = t - seq * L_P; }
    else { const int tt = t - T_P; const int s = tt / L_S; seq = NSEQ_P + s; pos = tt - s * L_S; }
}
__device__ __forceinline__ size_t vt_off(int seq, int head, int NH) {
    return seq < NSEQ_P ? (size_t)(seq * NH + head) * 64 * LPAD_P : (size_t)NSEQ_P * NH * 64 * LPAD_P + (size_t)((seq - NSEQ_P) * NH + head) * 64 * LPAD_S;
}

namespace pg8 {
constexpr int BM = 256, BK = 64, HALF = 128, HTB = HALF * BK * 2, STAGE_BYTES = 8 * HTB, NXCD = 8, WGM = 8;
__host__ __device__ __forceinline__ int lds_byte(int r, int c) { const int st = (r >> 4) * 2 + (c >> 5), rr = r & 15, cc = c & 31, ob = rr * 64 + cc * 2; return st * 1024 + (ob ^ (((ob >> 9) & 1) << 5)); }
__host__ __device__ __forceinline__ void stage_rc(int b, int& R, int& C) { const int st = b / 1024, sb = b % 1024, swz = sb ^ (((sb >> 9) & 1) << 5); R = (st >> 1) * 16 + swz / 64; C = (st & 1) * 32 + (swz % 64) / 2; }
struct Unit { int pm, pn; };
struct Gemm { const bf16_t* A; const bf16_t* Bt; int M, N, K, lda; };
struct StaticOrder {
    int nM, nN, nwg, G, c;
    __device__ void init(int M, int N, int G_, int c_) { nM = M / BM; nN = N / BM; nwg = nM * nN; G = G_; c = c_; }
    __device__ bool next(int i, Unit& u) const {
        const long L = (long)i * G + c; if (L >= nwg) return false;
        int wgid = (int)L; { const int q = nwg / NXCD, r = nwg % NXCD, xcd = wgid % NXCD, off = wgid / NXCD; wgid = (xcd < r ? xcd * (q + 1) : r * (q + 1) + (xcd - r) * q) + off; }
        const int nig = WGM * nN, gid = wgid / nig, fm = gid * WGM, gsz = (nM - fm) < WGM ? (nM - fm) : WGM;
        u.pm = fm + ((wgid % nig) % gsz); u.pn = (wgid % nig) / gsz; return true;
    }
};

template <class Epi>
__device__ __forceinline__ void gemm_phase(LAS unsigned char* lds, const Gemm g, const StaticOrder& S, const Epi& E) {
    const int tid = threadIdx.x, wid = __builtin_amdgcn_readfirstlane(tid >> 6), lane = tid & 63, wr = wid >> 2, wc = wid & 3, fr = lane & 15, fq = lane >> 4;
    int K_ = g.K, lda_ = g.lda; asm volatile("" : "+s"(K_), "+s"(lda_));
    const int K = K_, nt = K / BK, lda = lda_;
    unsigned voffA[2], voffB[2];
#pragma unroll
    for (int i = 0; i < 2; ++i) { int R, C; stage_rc(tid * 16 + i * 8192, R, C);
        voffA[i] = (unsigned)(R * lda + C) * 2u; voffB[i] = (unsigned)(R * K + C) * 2u; }
    const size_t kstep = (size_t)(BK * 2);
    const size_t hstepA = (size_t)HALF * lda * 2, hstepB = (size_t)HALF * K * 2;
    const size_t tstepA = 2 * hstepA, tstepB = 2 * hstepB;
    const unsigned ldsw = (unsigned)wid * 1024u;
    const int aoff = lds_byte(wr * 64 + fr, fq * 8), boff = lds_byte(wc * 32 + fr, fq * 8);
#define PG8_SA(b, h) (((b) * 2 + (h)) * HTB)
#define PG8_SB(b, h) ((4 + (b) * 2 + (h)) * HTB)
#define PG8_STAGE(bufoff, gbase, voff) do { _Pragma("unroll") for (int _i = 0; _i < 2; ++_i) \
        __builtin_amdgcn_global_load_lds((const unsigned*)((const char*)(gbase) + (voff)[_i]), (LAS unsigned*)(lds + (bufoff) + ldsw + _i * 8192), 16, 0, 0); } while (0)
#define PG8_LDA(dst, b, h) do { _Pragma("unroll") for (int m = 0; m < 4; ++m) _Pragma("unroll") for (int k = 0; k < 2; ++k) dst[m][k] = *(const LAS bf16x8*)(lds + PG8_SA(b, h) + aoff + m * 2048 + k * 1024); } while (0)
#define PG8_LDB(dst, b, h) do { _Pragma("unroll") for (int n = 0; n < 2; ++n) _Pragma("unroll") for (int k = 0; k < 2; ++k) dst[n][k] = *(const LAS bf16x8*)(lds + PG8_SB(b, h) + boff + n * 2048 + k * 1024); } while (0)
#define PG8_MMA(ai, bj, At, Bt) do { __builtin_amdgcn_s_setprio(1); _Pragma("unroll") for (int m = 0; m < 4; ++m) _Pragma("unroll") for (int n = 0; n < 2; ++n) _Pragma("unroll") for (int k = 0; k < 2; ++k) \
        acc[ai][bj][m][n] = __builtin_amdgcn_mfma_f32_16x16x32_bf16(Bt[n][k], At[m][k], acc[ai][bj][m][n], 0, 0, 0); __builtin_amdgcn_s_setprio(0); } while (0)
#define PG8_WAIT_V(n) asm volatile("s_waitcnt vmcnt(" #n ")" ::: "memory")
#define PG8_WAIT_L(n) asm volatile("s_waitcnt lgkmcnt(" #n ")" ::: "memory")
#define PG8_BAR __builtin_amdgcn_s_barrier()
#define PG8_SCHED __builtin_amdgcn_sched_barrier(0)
    Unit cur, nxt; int ui = 0;
    if (!S.next(0, cur)) return;
    f32x4 acc[2][2][4][2];
#pragma unroll
    for (int a = 0; a < 2; ++a)
#pragma unroll
        for (int b = 0; b < 2; ++b)
#pragma unroll
            for (int m = 0; m < 4; ++m)
#pragma unroll
                for (int n = 0; n < 2; ++n) acc[a][b][m][n] = (f32x4){0.f, 0.f, 0.f, 0.f};
    bf16x8 At[4][2], B0[2][2], B1[2][2];
    const char* cA = (const char*)g.A + (size_t)cur.pm * tstepA; const char* cB = (const char*)g.Bt + (size_t)cur.pn * tstepB;
    PG8_STAGE(PG8_SB(0, 0), cB, voffB); PG8_STAGE(PG8_SB(0, 1), cB + hstepB, voffB); PG8_STAGE(PG8_SA(0, 0), cA, voffA); PG8_STAGE(PG8_SA(0, 1), cA + hstepA, voffA);
    if (wr == 1) PG8_BAR;
    PG8_WAIT_V(2); PG8_BAR;
    PG8_STAGE(PG8_SB(1, 0), cB + kstep, voffB); PG8_STAGE(PG8_SA(1, 0), cA + kstep, voffA); PG8_STAGE(PG8_SB(1, 1), cB + hstepB + kstep, voffB);
    PG8_WAIT_V(6); PG8_BAR;
    for (;;) {
        const bool has_next = S.next(ui + 1, nxt);
        const char* nA = has_next ? (const char*)g.A + (size_t)nxt.pm * tstepA : cA; const char* nB = has_next ? (const char*)g.Bt + (size_t)nxt.pn * tstepB : cB;
        for (int t = 0; t < nt; t += 2) {
            const bool last = (t == nt - 2);
            const char* a1 = cA + (size_t)(t + 1) * kstep;
            const char* a2 = last ? nA : cA + (size_t)(t + 2) * kstep; const char* b2 = last ? nB : cB + (size_t)(t + 2) * kstep;
            const char* a3 = a2 + kstep; const char* b3 = b2 + kstep;
            PG8_LDB(B0, 0, 0); PG8_LDB(B1, 0, 1); PG8_SCHED; PG8_LDA(At, 0, 0); PG8_STAGE(PG8_SA(1, 1), a1 + hstepA, voffA);
            PG8_WAIT_V(8); PG8_WAIT_L(0); PG8_BAR; PG8_MMA(0, 0, At, B0); PG8_MMA(0, 1, At, B1); PG8_BAR; PG8_SCHED;
            PG8_LDA(At, 0, 1); PG8_STAGE(PG8_SB(0, 0), b2, voffB); PG8_STAGE(PG8_SB(0, 1), b2 + hstepB, voffB); PG8_STAGE(PG8_SA(0, 0), a2, voffA);
            PG8_WAIT_V(8); PG8_WAIT_L(0); PG8_BAR; PG8_MMA(1, 0, At, B0); PG8_MMA(1, 1, At, B1); PG8_BAR; PG8_SCHED;
            PG8_LDB(B0, 1, 0); PG8_LDB(B1, 1, 1); PG8_SCHED; PG8_LDA(At, 1, 0); PG8_STAGE(PG8_SA(0, 1), a2 + hstepA, voffA);
            PG8_WAIT_V(8); PG8_WAIT_L(0); PG8_BAR; PG8_MMA(0, 0, At, B0); PG8_MMA(0, 1, At, B1); PG8_BAR; PG8_SCHED;
            PG8_LDA(At, 1, 1); PG8_STAGE(PG8_SB(1, 0), b3, voffB); PG8_STAGE(PG8_SB(1, 1), b3 + hstepB, voffB); PG8_STAGE(PG8_SA(1, 0), a3, voffA);
            PG8_WAIT_V(8); PG8_WAIT_L(0); PG8_BAR; PG8_MMA(1, 0, At, B0); PG8_MMA(1, 1, At, B1); PG8_BAR; PG8_SCHED;
        }
        if (wr == 0) PG8_BAR;
        E(acc, cur, wr, wc, fr, fq);
        if (!has_next) break;
#pragma unroll
        for (int a = 0; a < 2; ++a)
#pragma unroll
            for (int b = 0; b < 2; ++b)
#pragma unroll
                for (int m = 0; m < 4; ++m)
#pragma unroll
                    for (int n = 0; n < 2; ++n) acc[a][b][m][n] = (f32x4){0.f, 0.f, 0.f, 0.f};
        cur = nxt; cA = nA; cB = nB; ++ui;
        if (wr == 1) PG8_BAR;
    }
    PG8_WAIT_V(0);
    PG8_BAR;
#undef PG8_SA
#undef PG8_SB
#undef PG8_STAGE
#undef PG8_LDA
#undef PG8_LDB
#undef PG8_MMA
#undef PG8_WAIT_V
#undef PG8_WAIT_L
#undef PG8_BAR
#undef PG8_SCHED
}

#define EPI_ARGS const f32x4 (&acc)[2][2][4][2], const Unit& u, int wr, int wc, int fr, int fq
#define EPI_ROW(ai, m) (u.pm * BM + (ai) * HALF + wr * 64 + (m) * 16 + fr)
#define EPI_COL(bj, n) (u.pn * BM + (bj) * HALF + wc * 32 + (n) * 16 + fq * 4)
__device__ __forceinline__ void st_bf16x4(bf16_t* p, f32x4 v) { u32x2 w; w.x = cvt_pk_bf16(v[0], v[1]); w.y = cvt_pk_bf16(v[2], v[3]); *(u32x2*)p = w; }

struct EpiStore {
    bf16_t* O; int ldc, ncols;
    __device__ __forceinline__ void operator()(EPI_ARGS) const {
#pragma unroll
        for (int ai = 0; ai < 2; ++ai)
#pragma unroll
            for (int m = 0; m < 4; ++m) { bf16_t* rowp = O + (size_t)EPI_ROW(ai, m) * ldc;
#pragma unroll
                for (int bj = 0; bj < 2; ++bj)
#pragma unroll
                    for (int n = 0; n < 2; ++n) { const int c = EPI_COL(bj, n); if (c < ncols) st_bf16x4(rowp + c, acc[ai][bj][m][n]); } }
    }
};
struct EpiRelu2 {
    bf16_t* O; int ldc;
    __device__ __forceinline__ void operator()(EPI_ARGS) const {
#pragma unroll
        for (int ai = 0; ai < 2; ++ai)
#pragma unroll
            for (int m = 0; m < 4; ++m) { bf16_t* rowp = O + (size_t)EPI_ROW(ai, m) * ldc;
#pragma unroll
                for (int bj = 0; bj < 2; ++bj)
#pragma unroll
                    for (int n = 0; n < 2; ++n) { f32x4 v = acc[ai][bj][m][n];
#pragma unroll
                        for (int j = 0; j < 4; ++j) { const float r = v[j] > 0.f ? v[j] : 0.f; v[j] = r * r; }
                        st_bf16x4(rowp + EPI_COL(bj, n), v); } }
    }
};
struct EpiRes {
    float* X;
    __device__ __forceinline__ void operator()(EPI_ARGS) const {
#pragma unroll
        for (int ai = 0; ai < 2; ++ai)
#pragma unroll
            for (int m = 0; m < 4; ++m) { float* rowp = X + (size_t)EPI_ROW(ai, m) * DM;
#pragma unroll
                for (int bj = 0; bj < 2; ++bj)
#pragma unroll
                    for (int n = 0; n < 2; ++n) { f32x4* p = (f32x4*)(rowp + EPI_COL(bj, n)); const f32x4 x = *p; *p = x * DN_ALPHA + acc[ai][bj][m][n]; } }
    }
};
struct EpiQ {
    bf16_t* O; const float* rs; const float* ropeA;
    __device__ __forceinline__ void operator()(EPI_ARGS) const {
#pragma unroll
        for (int ai = 0; ai < 2; ++ai)
#pragma unroll
            for (int m = 0; m < 4; ++m) { const int row = EPI_ROW(ai, m); bf16_t* rowp = O + (size_t)row * 1536; const float sc = rs[2 * row];
                int seq, pos; tok2sp(row, seq, pos);
                const f32x4 cs = *(const f32x4*)(ropeA + pos * 32 + fq * 4), sn = *(const f32x4*)(ropeA + pos * 32 + 16 + fq * 4);
#pragma unroll
                for (int bj = 0; bj < 2; ++bj) { const int g32 = (u.pn * BM + bj * HALF + wc * 32) >> 5;
                    f32x4 v0 = acc[ai][bj][m][0] * sc, v1 = acc[ai][bj][m][1] * sc;
                    if (g32 % 3 == 2) { const f32x4 a = v0 * cs - v1 * sn, b = v1 * cs + v0 * sn; v0 = a; v1 = b; }
                    st_bf16x4(rowp + EPI_COL(bj, 0), v0); st_bf16x4(rowp + EPI_COL(bj, 1), v1); }
                asm volatile("" ::: "memory"); }
    }
};
struct EpiScale {
    bf16_t* O; int ldc; const float* rs;
    __device__ __forceinline__ void operator()(EPI_ARGS) const {
#pragma unroll
        for (int ai = 0; ai < 2; ++ai)
#pragma unroll
            for (int m = 0; m < 4; ++m) { const int row = EPI_ROW(ai, m); bf16_t* rowp = O + (size_t)row * ldc; const float sc = rs[2 * row + 1];
#pragma unroll
                for (int bj = 0; bj < 2; ++bj)
#pragma unroll
                    for (int n = 0; n < 2; ++n) st_bf16x4(rowp + EPI_COL(bj, n), acc[ai][bj][m][n] * sc); }
    }
};
struct EpiVt {
    bf16_t* Vt; const float* rs; int NH;
    __device__ __forceinline__ void operator()(EPI_ARGS) const {
#pragma unroll
        for (int ai = 0; ai < 2; ++ai)
#pragma unroll
            for (int m = 0; m < 4; ++m) { const int row = EPI_ROW(ai, m); if (row >= T_ALL) continue;
                int seq, pos; tok2sp(row, seq, pos); const float sc = rs ? rs[2 * row + 1] : 1.f; const int lp = seq < NSEQ_P ? LPAD_P : LPAD_S; bf16_t* rb = Vt + vt_off(seq, 0, NH) + pos;
#pragma unroll
                for (int bj = 0; bj < 2; ++bj)
#pragma unroll
                    for (int n = 0; n < 2; ++n) { const int c = EPI_COL(bj, n); bf16_t* p = rb + (size_t)c * lp; const f32x4 v = acc[ai][bj][m][n] * sc;
                        const unsigned w0 = cvt_pk_bf16(v[0], v[1]), w1 = cvt_pk_bf16(v[2], v[3]);
                        p[0] = (bf16_t)(w0 & 0xffffu); p[lp] = (bf16_t)(w0 >> 16); p[2 * lp] = (bf16_t)(w1 & 0xffffu); p[3 * lp] = (bf16_t)(w1 >> 16); }
                asm volatile("" ::: "memory"); }
    }
};
struct EpiQK2 {
    bf16_t* O; const float* ropeB;
    __device__ __forceinline__ void operator()(EPI_ARGS) const {
        const bool ropew = (wc & 1) == 0;
#pragma unroll
        for (int ai = 0; ai < 2; ++ai)
#pragma unroll
            for (int m = 0; m < 4; ++m) { const int row = EPI_ROW(ai, m); bf16_t* rowp = O + (size_t)row * 1280;
                int seq, pos; tok2sp(row, seq, pos);
                const f32x4 cs = *(const f32x4*)(ropeB + pos * 16 + (fq & 1) * 4), sn = *(const f32x4*)(ropeB + pos * 16 + 8 + (fq & 1) * 4);
#pragma unroll
                for (int bj = 0; bj < 2; ++bj) { const float sc = (u.pn * BM + bj * HALF) < 1024 ? C2_GQA : 1.f;
                    f32x4 v0 = acc[ai][bj][m][0] * sc; const f32x4 v1 = acc[ai][bj][m][1] * sc;
                    f32x4 pr; pr[0] = __shfl_xor(v0[0], 32); pr[1] = __shfl_xor(v0[1], 32); pr[2] = __shfl_xor(v0[2], 32); pr[3] = __shfl_xor(v0[3], 32);
                    if (ropew) v0 = (fq < 2) ? (v0 * cs - pr * sn) : (v0 * cs + pr * sn);
                    st_bf16x4(rowp + EPI_COL(bj, 0), v0); st_bf16x4(rowp + EPI_COL(bj, 1), v1); } }
    }
};
}

constexpr int ATT_KP96 = 208, ATT_KP64 = 144, ATT_VP = 144;
constexpr int ATT_KBUF = 64 * 208, ATT_VBUF = 64 * ATT_VP, ATT_VOFF = 2 * ATT_KBUF;
__device__ __forceinline__ int crow(int r, int hi) { return (r & 3) + 8 * (r >> 2) + 4 * hi; }

struct AttnUnit {
    const bf16_t* Q; int ldq;
    const bf16_t* Kn; int ldk;
    const bf16_t* Kr;
    const bf16_t* Vt; int lpad;
    bf16_t* O;
    int L;
    int nvalid;
    int meta_first, t_lo, ntiles;
    int qpos0;
    float m0, l0;
};

template <int DQK, bool GQA>
__device__ __forceinline__ void attn_unit(LAS unsigned char* lds, const AttnUnit& a) {
    constexpr int KP = DQK == 96 ? ATT_KP96 : ATT_KP64, ND0 = DQK / 16;
    const int tid = threadIdx.x, lane = tid & 63, r32 = lane & 31, hi = lane >> 5;
    bf16x8 qf[ND0];
#pragma unroll
    for (int d0 = 0; d0 < ND0; ++d0) qf[d0] = *(const bf16x8*)(a.Q + (size_t)r32 * a.ldq + d0 * 16 + hi * 8);
    const int lk_key = tid >> 3, lk_ch = tid & 7, lr_key = tid >> 2, lr_ch = tid & 3;
    u32x4 gk, gr, gv;
    auto tile_of = [&](int i) -> int { return a.meta_first ? (i == 0 ? 0 : a.t_lo + i - 1) : a.t_lo + i; };
#define ATT_GLOAD(i) do { const int k0_ = tile_of(i) * 64; \
        gk = *(const u32x4*)(a.Kn + (size_t)(k0_ + lk_key) * a.ldk + lk_ch * 8); \
        if (DQK == 96) { if (tid < 256) gr = *(const u32x4*)(a.Kr + (size_t)(k0_ + lr_key) * 32 + lr_ch * 8); } \
        gv = *(const u32x4*)(a.Vt + (size_t)lk_key * a.lpad + k0_ + lk_ch * 8); } while (0)
#define ATT_LSTORE(buf) do { *(LAS u32x4*)(lds + (buf) * ATT_KBUF + lk_key * KP + lk_ch * 16) = gk; \
        if (DQK == 96) { if (tid < 256) *(LAS u32x4*)(lds + (buf) * ATT_KBUF + lr_key * KP + 128 + lr_ch * 16) = gr; } \
        *(LAS u32x4*)(lds + ATT_VOFF + (buf) * ATT_VBUF + lk_key * ATT_VP + lk_ch * 16) = gv; } while (0)
    float mrun = a.m0, lrun = (hi == 0) ? a.l0 : 0.f;
    f32x16 o[2]; o[0] = (f32x16){}; o[1] = (f32x16){};
    ATT_GLOAD(0); ATT_LSTORE(0);
    __syncthreads();
    for (int i = 0; i < a.ntiles; ++i) {
        const int buf = i & 1;
        if (i + 1 < a.ntiles) ATT_GLOAD(i + 1);
        const int k0 = tile_of(i) * 64;
        f32x16 p0 = (f32x16){}, p1 = (f32x16){};
        const LAS unsigned char* kb = lds + buf * ATT_KBUF + r32 * KP + hi * 16;
#pragma unroll
        for (int d0 = 0; d0 < ND0; ++d0) {
            const bf16x8 k0f = *(const LAS bf16x8*)(kb + d0 * 32), k1f = *(const LAS bf16x8*)(kb + 32 * KP + d0 * 32);
            p0 = __builtin_amdgcn_mfma_f32_32x32x16_bf16(k0f, qf[d0], p0, 0, 0, 0);
            p1 = __builtin_amdgcn_mfma_f32_32x32x16_bf16(k1f, qf[d0], p1, 0, 0, 0);
        }
        if (GQA) {
            const int qp = a.qpos0 + r32;
#pragma unroll
            for (int r = 0; r < 16; ++r) { const int ka = k0 + crow(r, hi), kb2 = ka + 32;
                const int da = qp - ka, db = qp - kb2;
                const bool va = ka < a.L && (ka < NMETA || (da <= 128 && da >= -128));
                const bool vb = kb2 < a.L && (kb2 < NMETA || (db <= 128 && db >= -128));
                if (!va) p0[r] = -INFINITY; if (!vb) p1[r] = -INFINITY; }
        } else if (k0 + 64 > a.L) {
#pragma unroll
            for (int r = 0; r < 16; ++r) { const int ka = k0 + crow(r, hi); if (ka >= a.L) p0[r] = -INFINITY; if (ka + 32 >= a.L) p1[r] = -INFINITY; }
        }
        float rm = fmaxf(p0[0], p1[0]);
#pragma unroll
        for (int r = 1; r < 16; ++r) rm = fmaxf(rm, fmaxf(p0[r], p1[r]));
        rm = fmaxf(rm, __shfl_xor(rm, 32));
        const float mnew = fmaxf(mrun, rm), alpha = __builtin_amdgcn_exp2f(mrun - mnew);
        mrun = mnew;
        float rs = 0.f;
#pragma unroll
        for (int r = 0; r < 16; ++r) { p0[r] = __builtin_amdgcn_exp2f(p0[r] - mnew); p1[r] = __builtin_amdgcn_exp2f(p1[r] - mnew); rs += p0[r] + p1[r]; }
        lrun = lrun * alpha + rs;
#pragma unroll
        for (int r = 0; r < 16; ++r) { o[0][r] *= alpha; o[1][r] *= alpha; }
        bf16x8 pb[4];
#pragma unroll
        for (int ks = 0; ks < 4; ++ks) { const int b = 8 * (ks & 1); u32x4 w;
            if (ks < 2) { w.x = cvt_pk_bf16(p0[b], p0[b + 1]); w.y = cvt_pk_bf16(p0[b + 2], p0[b + 3]); w.z = cvt_pk_bf16(p0[b + 4], p0[b + 5]); w.w = cvt_pk_bf16(p0[b + 6], p0[b + 7]); }
            else { w.x = cvt_pk_bf16(p1[b], p1[b + 1]); w.y = cvt_pk_bf16(p1[b + 2], p1[b + 3]); w.z = cvt_pk_bf16(p1[b + 4], p1[b + 5]); w.w = cvt_pk_bf16(p1[b + 6], p1[b + 7]); }
            pb[ks] = __builtin_bit_cast(bf16x8, w); }
        const LAS unsigned char* vb = lds + ATT_VOFF + buf * ATT_VBUF + r32 * ATT_VP + hi * 8;
#pragma unroll
        for (int d0 = 0; d0 < 2; ++d0)
#pragma unroll
            for (int ks = 0; ks < 4; ++ks) {
                const u32x2 lo = *(const LAS u32x2*)(vb + d0 * 32 * ATT_VP + ks * 32), hh = *(const LAS u32x2*)(vb + d0 * 32 * ATT_VP + ks * 32 + 16);
                const u32x4 w = (u32x4){lo.x, lo.y, hh.x, hh.y};
                o[d0] = __builtin_amdgcn_mfma_f32_32x32x16_bf16(__builtin_bit_cast(bf16x8, w), pb[ks], o[d0], 0, 0, 0);
            }
        if (i + 1 < a.ntiles) ATT_LSTORE(buf ^ 1);
        __syncthreads();
    }
#undef ATT_GLOAD
#undef ATT_LSTORE
    const float ltot = lrun + __shfl_xor(lrun, 32), inv = 1.f / ltot;
    if (r32 < a.nvalid) {
        bf16_t* op = a.O + (size_t)r32 * 1024 + hi * 4;
#pragma unroll
        for (int d0 = 0; d0 < 2; ++d0)
#pragma unroll
            for (int rg = 0; rg < 4; ++rg) { f32x4 v = (f32x4){o[d0][4 * rg], o[d0][4 * rg + 1], o[d0][4 * rg + 2], o[d0][4 * rg + 3]} * inv; pg8::st_bf16x4(op + d0 * 32 + rg * 8, v); }
    }
}

struct Params {
    const float* in[18]; float* out; unsigned char* ws;
    double invA[16]; double invB[8];
    int ph_lo, ph_hi;
};
constexpr int NPHASE = 16;
constexpr int LDS_BYTES = 147456;

__device__ __forceinline__ void transpose_item(const float* W, int K, int N, bf16_t* WT, int k0, int n0, int dst_n0, const float* gk, LAS float* scr, int lane) {
#pragma unroll 8
    for (int i = 0; i < 32; ++i) { const int kk = 2 * i + (lane >> 5); float v = W[(size_t)(k0 + kk) * N + n0 + (lane & 31)]; if (gk) v *= gk[k0 + kk]; scr[kk * 33 + (lane & 31)] = v; }
    asm volatile("s_waitcnt lgkmcnt(0)" ::: "memory");
    const int c = lane & 7;
#pragma unroll
    for (int j = 0; j < 4; ++j) { const int n = (lane >> 3) + 8 * j; const LAS float* s = scr + (8 * c) * 33 + n;
        u32x4 o; o.x = cvt_pk_bf16(s[0 * 33], s[1 * 33]); o.y = cvt_pk_bf16(s[2 * 33], s[3 * 33]); o.z = cvt_pk_bf16(s[4 * 33], s[5 * 33]); o.w = cvt_pk_bf16(s[6 * 33], s[7 * 33]);
        *(u32x4*)(WT + (size_t)(dst_n0 + n) * K + k0 + 8 * c) = o; }
    asm volatile("s_waitcnt lgkmcnt(0)" ::: "memory");
}

__device__ __forceinline__ void ln_row(const float* xrow, const float* g, const float* b, float* xo, bf16_t* ho, int lane) {
    const f32x4* xr = (const f32x4*)xrow + lane;
    f32x4 v[4]; float s = 0.f;
#pragma unroll
    for (int j = 0; j < 4; ++j) { v[j] = xr[64 * j]; s += (v[j][0] + v[j][1]) + (v[j][2] + v[j][3]); }
    const float mean = wave_sum(s) * (1.f / DM); float s2 = 0.f;
#pragma unroll
    for (int j = 0; j < 4; ++j) { v[j] = v[j] - mean; s2 += (v[j][0] * v[j][0] + v[j][1] * v[j][1]) + (v[j][2] * v[j][2] + v[j][3] * v[j][3]); }
    const float rstd = 1.f / sqrtf(wave_sum(s2) * (1.f / DM) + LN_EPS);
#pragma unroll
    for (int j = 0; j < 4; ++j) { const f32x4 gg = ((const f32x4*)g)[lane + 64 * j], bb = ((const f32x4*)b)[lane + 64 * j]; const f32x4 y = v[j] * rstd * gg + bb;
        if (xo) ((f32x4*)xo)[lane + 64 * j] = y;
        if (ho) pg8::st_bf16x4(ho + (size_t)(lane + 64 * j) * 4, y); }
}

__global__ void __launch_bounds__(512, 2) mega(Params p) {
    extern __shared__ __attribute__((aligned(16))) unsigned char lds_raw[];
    LAS unsigned char* lds = (LAS unsigned char*)lds_raw;
    const int tid = threadIdx.x, lane = tid & 63, wave = __builtin_amdgcn_readfirstlane(tid >> 6);
    const int G = gridDim.x, bid = blockIdx.x;
    const int gw = bid * 8 + wave, NGW = G * 8;
    unsigned char* ws = p.ws; unsigned char* ob = (unsigned char*)p.out;
    float* ropeA = (float*)(ws + WS_ROPEA); float* ropeB = (float*)(ws + WS_ROPEB); float* rsv = (float*)(ws + WS_RS);
    float* X = (float*)(ws + WS_X);
    bf16_t* Hb = (bf16_t*)(ob + O_H); bf16_t* VT = (bf16_t*)(ob + O_H); bf16_t* KR = (bf16_t*)(ob + O_KR);
    bf16_t* Cb = (bf16_t*)(ws + B_C); bf16_t* ATT = (bf16_t*)(ws + B_ATT); bf16_t* Qb = (bf16_t*)(ws + B_Q); bf16_t* KN = (bf16_t*)(ws + B_KN);
    bf16_t* VT2 = (bf16_t*)(ws + B_VT2); bf16_t* Ub = (bf16_t*)(ws + B_U);
    bf16_t* Win = (bf16_t*)(ws + W_IN); bf16_t* Wuq = (bf16_t*)(ws + W_UQ); bf16_t* Wukv = (bf16_t*)(ws + W_UKV); bf16_t* Wo0 = (bf16_t*)(ws + W_O0);
    bf16_t* Wqkv = (bf16_t*)(ws + W_QKV); bf16_t* Wo1 = (bf16_t*)(ws + W_O1); bf16_t* W1 = (bf16_t*)(ws + W_1); bf16_t* W2 = (bf16_t*)(ws + W_2);
    const float* x_prompt = p.in[0]; const float* x_sample = p.in[1]; const float* meta = p.in[2];
    const float* ln1_g = p.in[14]; const float* ln1_b = p.in[15]; const float* ln2_g = p.in[16]; const float* ln2_b = p.in[17];
    cg::grid_group grid = cg::this_grid();
    const int lo = p.ph_lo, hi_ph = p.ph_hi;
#ifndef PHMASK
#define PHMASK 0x1ffff
#endif
#define IN(k) (((PHMASK >> (k)) & 1) && lo <= (k) && (k) < hi_ph)
#define SEAM(k) do { if (IN(k) && IN((k) + 1)) grid.sync(); } while (0)
#define GEMM(EPI, Aptr, LDA, Bptr, NN, KK, ...) do { pg8::Gemm g_{Aptr, Bptr, TP, NN, KK, LDA}; pg8::StaticOrder S_; S_.init(TP, NN, G, bid); pg8::EPI E_{__VA_ARGS__}; pg8::gemm_phase<pg8::EPI>(lds, g_, S_, E_); } while (0)

    if (IN(0)) {
        LAS float* scr = (LAS float*)(lds + wave * 16384);
        for (int it = gw; it < 11344; it += NGW) {
            int mi, r = it, nbv;
            if (r < 528) { mi = 0; nbv = 33; } else if ((r -= 528) < 576) { mi = 1; nbv = 48; } else if ((r -= 576) < 256) { mi = 2; nbv = 64; } else if ((r -= 256) < 512) { mi = 3; nbv = 32; }
            else if ((r -= 512) < 768) { mi = 4; nbv = 48; } else if ((r -= 768) < 512) { mi = 5; nbv = 32; } else if ((r -= 512) < 2048) { mi = 6; nbv = 128; } else if ((r -= 2048) < 2048) { mi = 7; nbv = 128; }
            else if ((r -= 2048) < 2048) { mi = 8; nbv = 32; } else { r -= 2048; mi = 9; nbv = 32; }
            const int kbi = r / nbv, nbi = r % nbv, k0 = 64 * kbi, n0 = 32 * nbi;
            if (mi == 0) transpose_item(p.in[3], 1024, NC, Win, k0, n0, n0, nullptr, scr, lane);
            else if (mi == 1) transpose_item(p.in[5], 768, 1536, Wuq, k0, n0, n0, p.in[4], scr, lane);
            else if (mi == 2) { const int head = n0 >> 7, part = (n0 >> 6) & 1, d0 = n0 & 63; transpose_item(p.in[7], 256, 2048, Wukv, k0, n0, part * 1024 + head * 64 + d0, p.in[6], scr, lane); }
            else if (mi == 3) transpose_item(p.in[8], 1024, 1024, Wo0, k0, n0, n0, nullptr, scr, lane);
            else if (mi == 4) transpose_item(p.in[9], 1024, 1536, Wqkv, k0, n0, n0, nullptr, scr, lane);
            else if (mi == 5) transpose_item(p.in[11], 1024, 1024, Wo1, k0, n0, n0, nullptr, scr, lane);
            else if (mi == 6) transpose_item(p.in[12], 1024, 4096, W1, k0, n0, n0, nullptr, scr, lane);
            else if (mi == 7) transpose_item(p.in[12] + (size_t)1024 * 4096, 1024, 4096, W1 + (size_t)4096 * 1024, k0, n0, n0, nullptr, scr, lane);
            else if (mi == 8) transpose_item(p.in[13], 4096, 1024, W2, k0, n0, n0, nullptr, scr, lane);
            else transpose_item(p.in[13] + (size_t)4096 * 1024, 4096, 1024, W2 + (size_t)1024 * 4096, k0, n0, n0, nullptr, scr, lane);
        }
        for (int r = 1056 + gw; r < 1280; r += NGW) { u32x4* d = (u32x4*)(Win + (size_t)r * 1024); d[lane] = (u32x4){0, 0, 0, 0}; d[lane + 64] = (u32x4){0, 0, 0, 0}; }
        for (int t = gw; t < TP; t += NGW) {
            f32x4* xo = (f32x4*)(X + (size_t)t * DM); bf16_t* ho = Hb + (size_t)t * DM;
            if (t < T_ALL) { int seq, pos; tok2sp(t, seq, pos);
                const float* src = pos < NMETA ? meta + (size_t)pos * DM : (seq < NSEQ_P ? x_prompt + ((size_t)seq * 2048 + pos - NMETA) * DM : x_sample + ((size_t)(seq - NSEQ_P) * 4096 + pos - NMETA) * DM);
#pragma unroll
                for (int j = 0; j < 4; ++j) { const f32x4 v = ((const f32x4*)src)[lane + 64 * j]; xo[lane + 64 * j] = v; pg8::st_bf16x4(ho + (size_t)(lane + 64 * j) * 4, v); }
            } else {
#pragma unroll
                for (int j = 0; j < 4; ++j) { xo[lane + 64 * j] = (f32x4){0.f, 0.f, 0.f, 0.f}; *(u32x2*)(ho + (size_t)(lane + 64 * j) * 4) = (u32x2){0, 0}; }
            }
        }
        for (int e = bid * 512 + tid; e < 4112 * 24; e += G * 512) {
            const int pos = e / 24, i = e % 24; const double inv = i < 16 ? p.invA[i] : p.invB[i - 16];
            double rev = (double)pos * inv * 0.15915494309189535; rev -= floor(rev);
            const float fr_ = (float)rev; const float s = __builtin_amdgcn_sinf(fr_), c = __builtin_amdgcn_cosf(fr_);
            if (i < 16) { ropeA[pos * 32 + i] = c; ropeA[pos * 32 + 16 + i] = s; } else { ropeB[pos * 16 + i - 16] = c; ropeB[pos * 16 + 8 + i - 16] = s; }
        }
    }
    SEAM(0);
    if (IN(1)) GEMM(EpiStore, Hb, 1024, Win, 1280, 1024, Cb, NC, NC);
    SEAM(1);
    if (IN(2)) {
        for (int t = gw; t < TP; t += NGW) {
            const bf16_t* cr = Cb + (size_t)t * NC; float sq = 0.f, skv = 0.f;
#pragma unroll
            for (int j = 0; j < 3; ++j) { const u32x2 w = *(const u32x2*)(cr + lane * 12 + j * 4);
                const float a = __uint_as_float(w.x << 16), b = __uint_as_float(w.x & 0xffff0000u), c = __uint_as_float(w.y << 16), d = __uint_as_float(w.y & 0xffff0000u); sq += (a * a + b * b) + (c * c + d * d); }
            { const u32x2 w = *(const u32x2*)(cr + 768 + lane * 4);
                const float a = __uint_as_float(w.x << 16), b = __uint_as_float(w.x & 0xffff0000u), c = __uint_as_float(w.y << 16), d = __uint_as_float(w.y & 0xffff0000u); skv = (a * a + b * b) + (c * c + d * d); }
            sq = wave_sum(sq); skv = wave_sum(skv);
            if (lane == 0) { rsv[2 * t] = C2_MLA / sqrtf(sq * (1.f / 768.f) + RMS_EPS); rsv[2 * t + 1] = 1.f / sqrtf(skv * (1.f / 256.f) + RMS_EPS); }
            if (lane < 16) { int seq, pos; tok2sp(t, seq, pos);
                const float x1 = bf2f(cr[1024 + lane]), x2 = bf2f(cr[1040 + lane]), c = ropeA[pos * 32 + lane], s = ropeA[pos * 32 + 16 + lane];
                const unsigned w = cvt_pk_bf16(x1 * c - x2 * s, x2 * c + x1 * s);
                KR[(size_t)t * 32 + lane] = (bf16_t)(w & 0xffffu); KR[(size_t)t * 32 + 16 + lane] = (bf16_t)(w >> 16); }
        }
        for (int r = gw; r < 36 * 16 * 64; r += NGW) { const int sh = r >> 6, d = r & 63, seq = sh >> 4, head = sh & 15; const int lp = seq < NSEQ_P ? LPAD_P : LPAD_S, L = seq < NSEQ_P ? L_P : L_S;
            if (lane < 48) VT[vt_off(seq, head, 16) + (size_t)d * lp + L + lane] = 0; }
    }
    SEAM(2);
    if (IN(3)) {
#ifndef SK1
        GEMM(EpiQ, Cb, NC, Wuq, 1536, 768, Qb, rsv, ropeA);
#endif
#ifndef SK2
        GEMM(EpiScale, Cb + 768, NC, Wukv, 1024, 256, KN, 1024, rsv);
#endif
#ifndef SK3
        GEMM(EpiVt, Cb + 768, NC, Wukv + (size_t)1024 * 256, 1024, 256, VT, rsv, 16);
#endif
    }
    SEAM(3);
    if (IN(4)) {
        constexpr int NU_S = NSEQ_S * 16 * 17, NU_P = NSEQ_P * 16 * 9;
        for (int un = bid; un < NU_S + NU_P; un += G) {
            int seq, head, qb, L, tb, lp;
            if (un < NU_S) { seq = NSEQ_P + un / 272; const int r = un % 272; head = r / 17; qb = r % 17; L = L_S; tb = T_P + (seq - NSEQ_P) * L_S; lp = LPAD_S; }
            else { const int v = un - NU_S; seq = v / 144; const int r = v % 144; head = r / 9; qb = r % 9; L = L_P; tb = seq * L_P; lp = LPAD_P; }
            const int q0 = qb * 256 + wave * 32;
            AttnUnit a;
            a.Q = Qb + (size_t)(tb + q0) * 1536 + head * 96; a.ldq = 1536;
            a.Kn = KN + (size_t)tb * 1024 + head * 64; a.ldk = 1024; a.Kr = KR + (size_t)tb * 32;
            a.Vt = VT + vt_off(seq, head, 16); a.lpad = lp;
            a.O = ATT + (size_t)(tb + q0) * 1024 + head * 64;
            a.L = L; a.nvalid = L - q0; a.meta_first = 0; a.t_lo = 0; a.ntiles = (L + 63) / 64; a.qpos0 = q0; a.m0 = -1e30f; a.l0 = 0.f;
            attn_unit<96, false>(lds, a);
        }
    }
    SEAM(4);
    if (IN(5)) GEMM(EpiRes, ATT, 1024, Wo0, 1024, 1024, X);
    SEAM(5);
    if (IN(6)) for (int t = gw; t < TP; t += NGW) ln_row(X + (size_t)t * DM, ln1_g, ln1_b, X + (size_t)t * DM, Hb + (size_t)t * DM, lane);
    SEAM(6);
    if (IN(7)) GEMM(EpiRelu2, Hb, 1024, W1, 4096, 1024, Ub, DFF);
    SEAM(7);
    if (IN(8)) GEMM(EpiRes, Ub, DFF, W2, 1024, 4096, X);
    SEAM(8);
    if (IN(9)) {
        for (int t = gw; t < TP; t += NGW) ln_row(X + (size_t)t * DM, ln2_g, ln2_b, X + (size_t)t * DM, Hb + (size_t)t * DM, lane);
        for (int r = gw; r < 36 * 4 * 64; r += NGW) { const int sh = r >> 6, d = r & 63, seq = sh >> 2, head = sh & 3; const int lp = seq < NSEQ_P ? LPAD_P : LPAD_S, L = seq < NSEQ_P ? L_P : L_S;
            if (lane < 48) VT2[vt_off(seq, head, 4) + (size_t)d * lp + L + lane] = 0; }
    }
    SEAM(9);
    if (IN(10)) {
        GEMM(EpiQK2, Hb, 1024, Wqkv, 1280, 1024, Qb, ropeB);
        GEMM(EpiVt, Hb, 1024, Wqkv + (size_t)1280 * 1024, 256, 1024, VT2, nullptr, 4);
    }
    SEAM(10);
    if (IN(11)) {
        constexpr int NU_S = NSEQ_S * 4 * 65, NU_P = NSEQ_P * 4 * 33;
        const float* sink = p.in[10];
        for (int un = bid; un < NU_S + NU_P; un += G) {
            int seq, kvh, qb, L, tb, lp;
            if (un < NU_S) { seq = NSEQ_P + un / 260; const int r = un % 260; kvh = r / 65; qb = r % 65; L = L_S; tb = T_P + (seq - NSEQ_P) * L_S; lp = LPAD_S; }
            else { const int v = un - NU_S; seq = v / 132; const int r = v % 132; kvh = r / 33; qb = r % 33; L = L_P; tb = seq * L_P; lp = LPAD_P; }
            const int hq = kvh * 4 + (wave >> 1), q0 = qb * 64 + (wave & 1) * 32, NT = (L + 63) / 64;
            AttnUnit a;
            a.Q = Qb + (size_t)(tb + q0) * 1280 + hq * 64; a.ldq = 1280;
            a.Kn = Qb + (size_t)tb * 1280 + 1024 + kvh * 64; a.ldk = 1280; a.Kr = nullptr;
            a.Vt = VT2 + vt_off(seq, kvh, 4); a.lpad = lp;
            a.O = ATT + (size_t)(tb + q0) * 1024 + hq * 64;
            a.L = L; a.nvalid = L - q0;
            const int tlo = qb - 2 > 0 ? qb - 2 : 0, thi = qb + 2 < NT - 1 ? qb + 2 : NT - 1;
            a.meta_first = tlo > 0 ? 1 : 0; a.t_lo = tlo; a.ntiles = (thi - tlo + 1) + a.meta_first; a.qpos0 = q0;
            a.m0 = sink[hq] * LOG2E; a.l0 = 1.f;
            attn_unit<64, true>(lds, a);
        }
    }
    SEAM(11);
    if (IN(12)) GEMM(EpiRes, ATT, 1024, Wo1, 1024, 1024, X);
    SEAM(12);
    if (IN(13)) for (int t = gw; t < TP; t += NGW) ln_row(X + (size_t)t * DM, ln1_g + DM, ln1_b + DM, X + (size_t)t * DM, Hb + (size_t)t * DM, lane);
    SEAM(13);
    if (IN(14)) GEMM(EpiRelu2, Hb, 1024, W1 + (size_t)4096 * 1024, 4096, 1024, Ub, DFF);
    SEAM(14);
    if (IN(15)) GEMM(EpiRes, Ub, DFF, W2 + (size_t)1024 * 4096, 1024, 4096, X);
    SEAM(15);
    if (IN(16)) for (int t = gw; t < T_ALL; t += NGW) { int seq, pos; tok2sp(t, seq, pos); if (pos < NMETA) continue;
        const size_t orow = seq < NSEQ_P ? (size_t)seq * 2048 + pos - NMETA : (size_t)NSEQ_P * 2048 + (size_t)(seq - NSEQ_P) * 4096 + pos - NMETA;
        ln_row(X + (size_t)t * DM, ln2_g + DM, ln2_b + DM, p.out + orow * DM, nullptr, lane); }
#undef IN
#undef SEAM
#undef GEMM
}

extern "C" void kernel_launch(void* const* d_in, const int* in_sizes, int n_in, void* d_out, int out_size, void* d_ws, size_t ws_size, hipStream_t stream) {
    static int grid = 0;
    if (grid == 0) {
        if (n_in != 18 || ws_size < WS_NEED || (size_t)out_size < (size_t)81920 * 1024) { fprintf(stderr, "kernel_launch: unexpected problem (n_in %d, ws %zu, out %d)\n", n_in, ws_size, out_size); grid = -1; return; }
        int dev = 0, cus = 0, per_cu = 0;
        hipGetDevice(&dev); hipDeviceGetAttribute(&cus, hipDeviceAttributeMultiprocessorCount, dev);
        hipFuncSetAttribute((const void*)mega, hipFuncAttributeMaxDynamicSharedMemorySize, LDS_BYTES);
        hipOccupancyMaxActiveBlocksPerMultiprocessor(&per_cu, (const void*)mega, 512, LDS_BYTES);
        (void)hipGetLastError();
        if (per_cu < 1) per_cu = 1;
        grid = cus * per_cu;
    }
    if (grid < 0) return;
    Params p{};
    for (int i = 0; i < 18; ++i) p.in[i] = (const float*)d_in[i];
    p.out = (float*)d_out; p.ws = (unsigned char*)d_ws;
    for (int i = 0; i < 16; ++i) p.invA[i] = std::pow(500000.0, -(double)(2 * i) / 32.0);
    for (int i = 0; i < 8; ++i) p.invB[i] = std::pow(500000.0, -(double)(2 * i) / 16.0);
#if MK_PER_PHASE
    for (int ph = 0; ph <= NPHASE; ++ph) { p.ph_lo = ph; p.ph_hi = ph + 1; hipLaunchKernelGGL(mega, dim3(grid), dim3(512), LDS_BYTES, stream, p); }
#else
    p.ph_lo = 0; p.ph_hi = NPHASE + 1;
    void* args[] = {&p};
    hipError_t e = hipLaunchCooperativeKernel((const void*)mega, dim3(grid), dim3(512), args, LDS_BYTES, stream);
    if (e != hipSuccess) fprintf(stderr, "cooperative launch failed: %s (grid %d)\n", hipGetErrorString(e), grid);
#endif
}
```

```cpp
#include <hip/hip_runtime.h>
#include <hip/hip_cooperative_groups.h>
#include <cstdio>
#include <cstdint>
#include <cmath>
namespace cg = cooperative_groups;

#ifndef MK_PER_PHASE
#define MK_PER_PHASE 0
#endif

#define LAS __attribute__((address_space(3)))
typedef unsigned short bf16_t;
typedef short bf16x8 __attribute__((ext_vector_type(8)));
typedef float f32x4 __attribute__((ext_vector_type(4)));
typedef float f32x16 __attribute__((ext_vector_type(16)));
typedef unsigned u32x4 __attribute__((ext_vector_type(4)));
typedef unsigned u32x2 __attribute__((ext_vector_type(2)));

constexpr int DM = 1024, NMETA = 16;
constexpr int NSEQ_P = 32, L_P = 2048 + NMETA, NSEQ_S = 4, L_S = 4096 + NMETA;
constexpr int T_P = NSEQ_P * L_P;
constexpr int T_ALL = T_P + NSEQ_S * L_S;
constexpr int TP = 82688;
constexpr int LPAD_P = L_P, LPAD_S = L_S;
constexpr int NC = 1056;
constexpr int DFF = 4096;
constexpr float LN_EPS = 1e-5f, RMS_EPS = 1e-6f;
constexpr float DN_ALPHA = 1.4142135623730951f;
constexpr float LOG2E = 1.4426950408889634f;
constexpr float C2_MLA = 0.10206207261596575f * LOG2E;
constexpr float C2_GQA = 0.125f * LOG2E;

constexpr size_t MiB = 1u << 20;
constexpr size_t WS_ROPEA = 1 * MiB;
constexpr size_t WS_ROPEB = WS_ROPEA + 4112 * 32 * 4;
constexpr size_t WS_RS = WS_ROPEB + 4112 * 16 * 4;
constexpr size_t WS_W = 2 * MiB;
constexpr size_t W_IN = WS_W;
constexpr size_t W_UQ = W_IN + 1280 * 1024 * 2;
constexpr size_t W_UKV = W_UQ + 1536 * 768 * 2;
constexpr size_t W_O0 = W_UKV + 2048 * 256 * 2;
constexpr size_t W_QKV = W_O0 + 1024 * 1024 * 2;
constexpr size_t W_O1 = W_QKV + 1536 * 1024 * 2;
constexpr size_t W_1 = W_O1 + 1024 * 1024 * 2;
constexpr size_t W_2 = W_1 + 2 * (size_t)4096 * 1024 * 2;
constexpr size_t W_END = W_2 + 2 * (size_t)4096 * 1024 * 2;
constexpr size_t WS_X = 47 * MiB;
constexpr size_t WS_VT = 209 * MiB;
constexpr size_t WS_BIG = 371 * MiB;
constexpr size_t B_C = WS_BIG;
constexpr size_t B_ATT = WS_BIG;
constexpr size_t B_Q = WS_BIG + 168 * MiB;
constexpr size_t B_KN = WS_BIG + 411 * MiB;
constexpr size_t B_VT2 = WS_BIG + 372 * MiB;
constexpr size_t B_U = WS_BIG;
constexpr size_t WS_NEED = WS_BIG + 646 * MiB;
static_assert(W_END <= WS_X, "weights fit");
constexpr size_t O_H = 0;
constexpr size_t O_KR = 166 * MiB;
constexpr size_t VT_S_OFF16 = (size_t)NSEQ_P * 16 * 64 * LPAD_P;
constexpr size_t VT_S_OFF4 = (size_t)NSEQ_P * 4 * 64 * LPAD_P;

#define GAS __attribute__((address_space(1)))
template <class T> __device__ __forceinline__ T ldg(const void* p) { return *(const GAS T*)p; }
template <class T> __device__ __forceinline__ void stg(void* p, T v) { *(GAS T*)p = v; }
__device__ __forceinline__ unsigned cvt_pk_bf16(float lo, float hi) { unsigned r; asm volatile("v_cvt_pk_bf16_f32 %0, %1, %2" : "=v"(r) : "v"(lo), "v"(hi)); return r; }
__device__ __forceinline__ float bf2f(unsigned short b) { return __uint_as_float((unsigned)b << 16); }
__device__ __forceinline__ float wave_sum(float v) {
#pragma unroll
    for (int o = 1; o < 64; o <<= 1) v += __shfl_xor(v, o);
    return v;
}
__device__ __forceinline__ void tok2sp(int t, int& seq, int& pos) {
    if (t < T_P) { seq = t / L_P; pos = t - seq * L_P; }
    else { const int tt = t - T_P; const int s = tt / L_S; seq = NSEQ_P + s; pos = tt - s * L_S; }
}
__device__ __forceinline__ size_t vt_off(int seq, int head, int NH) {
    return seq < NSEQ_P ? (size_t)(seq * NH + head) * 64 * LPAD_P : (size_t)NSEQ_P * NH * 64 * LPAD_P + (size_t)((seq - NSEQ_P) * NH + head) * 64 * LPAD_S;
}

namespace pg8 {
constexpr int BM = 256, BK = 64, HALF = 128, HTB = HALF * BK * 2, STAGE_BYTES = 8 * HTB, NXCD = 8, WGM = 8;
__host__ __device__ __forceinline__ int lds_byte(int r, int c) { const int st = (r >> 4) * 2 + (c >> 5), rr = r & 15, cc = c & 31, ob = rr * 64 + cc * 2; return st * 1024 + (ob ^ (((ob >> 9) & 1) << 5)); }
__host__ __device__ __forceinline__ void stage_rc(int b, int& R, int& C) { const int st = b / 1024, sb = b % 1024, swz = sb ^ (((sb >> 9) & 1) << 5); R = (st >> 1) * 16 + swz / 64; C = (st & 1) * 32 + (swz % 64) / 2; }
struct Unit { int pm, pn; };
struct Gemm { const bf16_t* A; const bf16_t* Bt; int M, N, K, lda; };
struct StaticOrder {
    int nM, nN, nwg, G, c;
    __device__ void init(int M, int N, int G_, int c_) { nM = M / BM; nN = N / BM; nwg = nM * nN; G = G_; c = c_; }
    __device__ bool next(int i, Unit& u) const {
        const long L = (long)i * G + c; if (L >= nwg) return false;
        int wgid = (int)L; { const int q = nwg / NXCD, r = nwg % NXCD, xcd = wgid % NXCD, off = wgid / NXCD; wgid = (xcd < r ? xcd * (q + 1) : r * (q + 1) + (xcd - r) * q) + off; }
        const int nig = WGM * nN, gid = wgid / nig, fm = gid * WGM, gsz = (nM - fm) < WGM ? (nM - fm) : WGM;
        u.pm = fm + ((wgid % nig) % gsz); u.pn = (wgid % nig) / gsz; return true;
    }
};

template <class Epi>
__device__ __forceinline__ void gemm_phase(LAS unsigned char* lds, const Gemm g, const StaticOrder& S, const Epi& E) {
    const int tid = threadIdx.x, wid = __builtin_amdgcn_readfirstlane(tid >> 6), lane = tid & 63, wr = wid >> 2, wc = wid & 3, fr = lane & 15, fq = lane >> 4;
    int K_ = g.K, lda_ = g.lda; asm volatile("" : "+s"(K_), "+s"(lda_));
    const int K = K_, nt = K / BK, lda = lda_;
    unsigned voffA[2], voffB[2];
#pragma unroll
    for (int i = 0; i < 2; ++i) { int R, C; stage_rc(tid * 16 + i * 8192, R, C);
        voffA[i] = (unsigned)(R * lda + C) * 2u; voffB[i] = (unsigned)(R * K + C) * 2u; }
    const size_t kstep = (size_t)(BK * 2);
    const size_t hstepA = (size_t)HALF * lda * 2, hstepB = (size_t)HALF * K * 2;
    const size_t tstepA = 2 * hstepA, tstepB = 2 * hstepB;
    const unsigned ldsw = (unsigned)wid * 1024u;
    const int aoff = lds_byte(wr * 64 + fr, fq * 8), boff = lds_byte(wc * 32 + fr, fq * 8);
#define PG8_SA(b, h) (((b) * 2 + (h)) * HTB)
#define PG8_SB(b, h) ((4 + (b) * 2 + (h)) * HTB)
#define PG8_STAGE(bufoff, gbase, voff) do { _Pragma("unroll") for (int _i = 0; _i < 2; ++_i) \
        __builtin_amdgcn_global_load_lds((const unsigned*)((const char*)(gbase) + (voff)[_i]), (LAS unsigned*)(lds + (bufoff) + ldsw + _i * 8192), 16, 0, 0); } while (0)
#define PG8_LDA(dst, b, h) do { _Pragma("unroll") for (int m = 0; m < 4; ++m) _Pragma("unroll") for (int k = 0; k < 2; ++k) dst[m][k] = *(const LAS bf16x8*)(lds + PG8_SA(b, h) + aoff + m * 2048 + k * 1024); } while (0)
#define PG8_LDB(dst, b, h) do { _Pragma("unroll") for (int n = 0; n < 2; ++n) _Pragma("unroll") for (int k = 0; k < 2; ++k) dst[n][k] = *(const LAS bf16x8*)(lds + PG8_SB(b, h) + boff + n * 2048 + k * 1024); } while (0)
#define PG8_MMA(ai, bj, At, Bt) do { __builtin_amdgcn_s_setprio(1); _Pragma("unroll") for (int m = 0; m < 4; ++m) _Pragma("unroll") for (int n = 0; n < 2; ++n) _Pragma("unroll") for (int k = 0; k < 2; ++k) \
        acc[ai][bj][m][n] = __builtin_amdgcn_mfma_f32_16x16x32_bf16(Bt[n][k], At[m][k], acc[ai][bj][m][n], 0, 0, 0); __builtin_amdgcn_s_setprio(0); } while (0)
#define PG8_WAIT_V(n) asm volatile("s_waitcnt vmcnt(" #n ")" ::: "memory")
#define PG8_WAIT_L(n) asm volatile("s_waitcnt lgkmcnt(" #n ")" ::: "memory")
#define PG8_BAR __builtin_amdgcn_s_barrier()
#define PG8_SCHED __builtin_amdgcn_sched_barrier(0)
    Unit cur, nxt; int ui = 0;
    if (!S.next(0, cur)) return;
    f32x4 acc[2][2][4][2];
#pragma unroll
    for (int a = 0; a < 2; ++a)
#pragma unroll
        for (int b = 0; b < 2; ++b)
#pragma unroll
            for (int m = 0; m < 4; ++m)
#pragma unroll
                for (int n = 0; n < 2; ++n) acc[a][b][m][n] = (f32x4){0.f, 0.f, 0.f, 0.f};
    bf16x8 At[4][2], B0[2][2], B1[2][2];
    const char* cA = (const char*)g.A + (size_t)cur.pm * tstepA; const char* cB = (const char*)g.Bt + (size_t)cur.pn * tstepB;
    PG8_STAGE(PG8_SB(0, 0), cB, voffB); PG8_STAGE(PG8_SB(0, 1), cB + hstepB, voffB); PG8_STAGE(PG8_SA(0, 0), cA, voffA); PG8_STAGE(PG8_SA(0, 1), cA + hstepA, voffA);
    if (wr == 1) PG8_BAR;
    PG8_WAIT_V(2); PG8_BAR;
    PG8_STAGE(PG8_SB(1, 0), cB + kstep, voffB); PG8_STAGE(PG8_SA(1, 0), cA + kstep, voffA); PG8_STAGE(PG8_SB(1, 1), cB + hstepB + kstep, voffB);
    PG8_WAIT_V(6); PG8_BAR;
    for (;;) {
        const bool has_next = S.next(ui + 1, nxt);
        const char* nA = has_next ? (const char*)g.A + (size_t)nxt.pm * tstepA : cA; const char* nB = has_next ? (const char*)g.Bt + (size_t)nxt.pn * tstepB : cB;
        for (int t = 0; t < nt; t += 2) {
            const bool last = (t == nt - 2);
            const char* a1 = cA + (size_t)(t + 1) * kstep;
            const char* a2 = last ? nA : cA + (size_t)(t + 2) * kstep; const char* b2 = last ? nB : cB + (size_t)(t + 2) * kstep;
            const char* a3 = a2 + kstep; const char* b3 = b2 + kstep;
            PG8_LDB(B0, 0, 0); PG8_LDB(B1, 0, 1); PG8_SCHED; PG8_LDA(At, 0, 0); PG8_STAGE(PG8_SA(1, 1), a1 + hstepA, voffA);
            PG8_WAIT_V(8); PG8_WAIT_L(0); PG8_BAR; PG8_MMA(0, 0, At, B0); PG8_MMA(0, 1, At, B1); PG8_BAR; PG8_SCHED;
            PG8_LDA(At, 0, 1); PG8_STAGE(PG8_SB(0, 0), b2, voffB); PG8_STAGE(PG8_SB(0, 1), b2 + hstepB, voffB); PG8_STAGE(PG8_SA(0, 0), a2, voffA);
            PG8_WAIT_V(8); PG8_WAIT_L(0); PG8_BAR; PG8_MMA(1, 0, At, B0); PG8_MMA(1, 1, At, B1); PG8_BAR; PG8_SCHED;
            PG8_LDB(B0, 1, 0); PG8_LDB(B1, 1, 1); PG8_SCHED; PG8_LDA(At, 1, 0); PG8_STAGE(PG8_SA(0, 1), a2 + hstepA, voffA);
            PG8_WAIT_V(8); PG8_WAIT_L(0); PG8_BAR; PG8_MMA(0, 0, At, B0); PG8_MMA(0, 1, At, B1); PG8_BAR; PG8_SCHED;
            PG8_LDA(At, 1, 1); PG8_STAGE(PG8_SB(1, 0), b3, voffB); PG8_STAGE(PG8_SB(1, 1), b3 + hstepB, voffB); PG8_STAGE(PG8_SA(1, 0), a3, voffA);
            PG8_WAIT_V(8); PG8_WAIT_L(0); PG8_BAR; PG8_MMA(1, 0, At, B0); PG8_MMA(1, 1, At, B1); PG8_BAR; PG8_SCHED;
        }
        if (wr == 0) PG8_BAR;
        E(acc, cur, wr, wc, fr, fq);
        if (!has_next) break;
#pragma unroll
        for (int a = 0; a < 2; ++a)
#pragma unroll
            for (int b = 0; b < 2; ++b)
#pragma unroll
                for (int m = 0; m < 4; ++m)
#pragma unroll
                    for (int n = 0; n < 2; ++n) acc[a][b][m][n] = (f32x4){0.f, 0.f, 0.f, 0.f};
        cur = nxt; cA = nA; cB = nB; ++ui;
        if (wr == 1) PG8_BAR;
    }
    PG8_WAIT_V(0);
    PG8_BAR;
#undef PG8_SA
#undef PG8_SB
#undef PG8_STAGE
#undef PG8_LDA
#undef PG8_LDB
#undef PG8_MMA
#undef PG8_WAIT_V
#undef PG8_WAIT_L
#undef PG8_BAR
#undef PG8_SCHED
}

#define EPI_ARGS const f32x4 (&acc)[2][2][4][2], const Unit& u, int wr, int wc, int fr, int fq
#define EPI_ROW(ai, m) (u.pm * BM + (ai) * HALF + wr * 64 + (m) * 16 + fr)
#define EPI_COL(bj, n) (u.pn * BM + (bj) * HALF + wc * 32 + (n) * 16 + fq * 4)
__device__ __forceinline__ void st_bf16x4(bf16_t* p, f32x4 v) { u32x2 w; w.x = cvt_pk_bf16(v[0], v[1]); w.y = cvt_pk_bf16(v[2], v[3]); stg<u32x2>(p, w); }

struct EpiStore {
    bf16_t* O; int ldc, ncols;
    __device__ __forceinline__ void operator()(EPI_ARGS) const {
#pragma unroll
        for (int ai = 0; ai < 2; ++ai)
#pragma unroll
            for (int m = 0; m < 4; ++m) { bf16_t* rowp = O + (size_t)EPI_ROW(ai, m) * ldc;
#pragma unroll
                for (int bj = 0; bj < 2; ++bj)
#pragma unroll
                    for (int n = 0; n < 2; ++n) { const int c = EPI_COL(bj, n); if (c < ncols) st_bf16x4(rowp + c, acc[ai][bj][m][n]); } }
    }
};
struct EpiRelu2 {
    bf16_t* O; int ldc;
    __device__ __forceinline__ void operator()(EPI_ARGS) const {
#pragma unroll
        for (int ai = 0; ai < 2; ++ai)
#pragma unroll
            for (int m = 0; m < 4; ++m) { bf16_t* rowp = O + (size_t)EPI_ROW(ai, m) * ldc;
#pragma unroll
                for (int bj = 0; bj < 2; ++bj)
#pragma unroll
                    for (int n = 0; n < 2; ++n) { f32x4 v = acc[ai][bj][m][n];
#pragma unroll
                        for (int j = 0; j < 4; ++j) { const float r = v[j] > 0.f ? v[j] : 0.f; v[j] = r * r; }
                        st_bf16x4(rowp + EPI_COL(bj, n), v); } }
    }
};
struct EpiRes {
    const bf16_t* H; bf16_t* P;
    __device__ __forceinline__ void operator()(EPI_ARGS) const {
#pragma unroll
        for (int ai = 0; ai < 2; ++ai)
#pragma unroll
            for (int m = 0; m < 4; ++m) { const size_t ro = (size_t)EPI_ROW(ai, m) * DM;
#pragma unroll
                for (int bj = 0; bj < 2; ++bj)
#pragma unroll
                    for (int n = 0; n < 2; ++n) { const int c = EPI_COL(bj, n); const u32x2 w = ldg<u32x2>(H + ro + c);
                        const f32x4 x = (f32x4){__uint_as_float(w.x << 16), __uint_as_float(w.x & 0xffff0000u), __uint_as_float(w.y << 16), __uint_as_float(w.y & 0xffff0000u)};
                        st_bf16x4(P + ro + c, x * DN_ALPHA + acc[ai][bj][m][n]); } }
    }
};
struct EpiQ {
    bf16_t* O; const float* rs; const float* ropeA;
    __device__ __forceinline__ void operator()(EPI_ARGS) const {
#pragma unroll
        for (int ai = 0; ai < 2; ++ai)
#pragma unroll
            for (int m = 0; m < 4; ++m) { const int row = EPI_ROW(ai, m); bf16_t* rowp = O + (size_t)row * 1536; const float sc = ldg<float>(rs + 2 * row);
                int seq, pos; tok2sp(row, seq, pos);
                const f32x4 cs = ldg<f32x4>(ropeA + pos * 32 + fq * 4), sn = ldg<f32x4>(ropeA + pos * 32 + 16 + fq * 4);
#pragma unroll
                for (int bj = 0; bj < 2; ++bj) { const int g32 = (u.pn * BM + bj * HALF + wc * 32) >> 5;
                    f32x4 v0 = acc[ai][bj][m][0] * sc, v1 = acc[ai][bj][m][1] * sc;
                    if (g32 % 3 == 2) { const f32x4 a = v0 * cs - v1 * sn, b = v1 * cs + v0 * sn; v0 = a; v1 = b; }
                    st_bf16x4(rowp + EPI_COL(bj, 0), v0); st_bf16x4(rowp + EPI_COL(bj, 1), v1); }
                asm volatile("" ::: "memory"); }
    }
};
struct EpiScale {
    bf16_t* O; int ldc; const float* rs;
    __device__ __forceinline__ void operator()(EPI_ARGS) const {
#pragma unroll
        for (int ai = 0; ai < 2; ++ai)
#pragma unroll
            for (int m = 0; m < 4; ++m) { const int row = EPI_ROW(ai, m); bf16_t* rowp = O + (size_t)row * ldc; const float sc = ldg<float>(rs + 2 * row + 1);
#pragma unroll
                for (int bj = 0; bj < 2; ++bj)
#pragma unroll
                    for (int n = 0; n < 2; ++n) st_bf16x4(rowp + EPI_COL(bj, n), acc[ai][bj][m][n] * sc); }
    }
};
struct EpiVt {
    bf16_t* Vt; const float* rs; int NH;
    __device__ __forceinline__ void operator()(EPI_ARGS) const {
#pragma unroll
        for (int ai = 0; ai < 2; ++ai)
#pragma unroll
            for (int m = 0; m < 4; ++m) { const int row = EPI_ROW(ai, m); if (row >= T_ALL) continue;
                int seq, pos; tok2sp(row, seq, pos); const float sc = rs ? ldg<float>(rs + 2 * row + 1) : 1.f; const int lp = seq < NSEQ_P ? LPAD_P : LPAD_S; bf16_t* rb = Vt + vt_off(seq, 0, NH) + pos;
#pragma unroll
                for (int bj = 0; bj < 2; ++bj)
#pragma unroll
                    for (int n = 0; n < 2; ++n) { const int c = EPI_COL(bj, n); bf16_t* p = rb + (size_t)c * lp; const f32x4 v = acc[ai][bj][m][n] * sc;
                        const unsigned w0 = cvt_pk_bf16(v[0], v[1]), w1 = cvt_pk_bf16(v[2], v[3]);
                        stg<bf16_t>(p, (bf16_t)(w0 & 0xffffu)); stg<bf16_t>(p + lp, (bf16_t)(w0 >> 16)); stg<bf16_t>(p + 2 * lp, (bf16_t)(w1 & 0xffffu)); stg<bf16_t>(p + 3 * lp, (bf16_t)(w1 >> 16)); }
                asm volatile("" ::: "memory"); }
    }
};
struct EpiQK2 {
    bf16_t* O; const float* ropeB;
    __device__ __forceinline__ void operator()(EPI_ARGS) const {
        const bool ropew = (wc & 1) == 0;
#pragma unroll
        for (int ai = 0; ai < 2; ++ai)
#pragma unroll
            for (int m = 0; m < 4; ++m) { const int row = EPI_ROW(ai, m); bf16_t* rowp = O + (size_t)row * 1280;
                int seq, pos; tok2sp(row, seq, pos);
                const f32x4 cs = ldg<f32x4>(ropeB + pos * 16 + (fq & 1) * 4), sn = ldg<f32x4>(ropeB + pos * 16 + 8 + (fq & 1) * 4);
#pragma unroll
                for (int bj = 0; bj < 2; ++bj) { const float sc = (u.pn * BM + bj * HALF) < 1024 ? C2_GQA : 1.f;
                    f32x4 v0 = acc[ai][bj][m][0] * sc; const f32x4 v1 = acc[ai][bj][m][1] * sc;
                    f32x4 pr; pr[0] = __shfl_xor(v0[0], 32); pr[1] = __shfl_xor(v0[1], 32); pr[2] = __shfl_xor(v0[2], 32); pr[3] = __shfl_xor(v0[3], 32);
                    if (ropew) v0 = (fq < 2) ? (v0 * cs - pr * sn) : (v0 * cs + pr * sn);
                    st_bf16x4(rowp + EPI_COL(bj, 0), v0); st_bf16x4(rowp + EPI_COL(bj, 1), v1); } }
    }
};
}

constexpr int ATT_KP96 = 208, ATT_KP64 = 144, ATT_VP = 144;
__device__ __forceinline__ int crow(int r, int hi) { return (r & 3) + 8 * (r >> 2) + 4 * hi; }

struct AttnUnit {
    const bf16_t* Q; int ldq;
    const bf16_t* Kn; int ldk;
    const bf16_t* Kr;
    const bf16_t* Vt; int lpad;
    bf16_t* O;
    int L;
    int nvalid;
    int meta_first, t_lo, ntiles;
    int qpos0;
    float m0, l0;
};

template <int DQK, bool GQA>
__device__ __forceinline__ void attn_unit(LAS unsigned char* lds, const AttnUnit& a) {
    constexpr int KP = DQK == 96 ? ATT_KP96 : ATT_KP64, ND0 = DQK / 16;
    constexpr int KSUB = 64 * KP, VSUB = 64 * ATT_VP, STAGE = KSUB + VSUB;
    const int tid = threadIdx.x, lane = tid & 63, r32 = lane & 31, hi = lane >> 5;
    bf16x8 qf[ND0];
#pragma unroll
    for (int d0 = 0; d0 < ND0; ++d0) qf[d0] = ldg<bf16x8>(a.Q + (size_t)r32 * a.ldq + d0 * 16 + hi * 8);
    const int lk_key = tid >> 3, lk_ch = tid & 7, lk_row = (lk_key & ~12) | (((lk_key >> 2) & 1) << 3) | (((lk_key >> 3) & 1) << 2);
    const int lr_key = (tid >> 2) & 63, lr_ch = tid & 3, lr_row = (lr_key & ~12) | (((lr_key >> 2) & 1) << 3) | (((lr_key >> 3) & 1) << 2);
    u32x4 gk, gv, gr;
    auto tile_of = [&](int i) -> int { return a.meta_first ? (i == 0 ? 0 : a.t_lo + i - 1) : a.t_lo + i; };
#define ATT_GLOAD(i) do { const int k0_ = tile_of(i) * 64; \
        gk = ldg<u32x4>(a.Kn + (size_t)(k0_ + lk_key) * a.ldk + lk_ch * 8); \
        if (DQK == 96) { if (tid < 256) gr = ldg<u32x4>(a.Kr + (size_t)(k0_ + lr_key) * 32 + lr_ch * 8); } \
        gv = ldg<u32x4>(a.Vt + (size_t)lk_key * a.lpad + k0_ + lk_ch * 8); } while (0)
#define ATT_LSTORE(s) do { LAS unsigned char* b_ = lds + (s) * STAGE; \
        *(LAS u32x4*)(b_ + lk_row * KP + lk_ch * 16) = gk; \
        if (DQK == 96) { if (tid < 256) *(LAS u32x4*)(b_ + lr_row * KP + 128 + lr_ch * 16) = gr; } \
        *(LAS u32x4*)(b_ + KSUB + lk_key * ATT_VP + lk_ch * 16) = gv; } while (0)
#define SBAR() __builtin_amdgcn_sched_barrier(0)
    float mref = a.m0, lrun = (hi == 0) ? a.l0 : 0.f;
    f32x16 negm;
#pragma unroll
    for (int r = 0; r < 16; ++r) negm[r] = -mref;
    f32x16 o[2]; o[0] = (f32x16){}; o[1] = (f32x16){};
    const int qp = a.qpos0 + r32;
    ATT_GLOAD(0); ATT_LSTORE(0);
    __syncthreads();
    for (int i = 0; i < a.ntiles; ++i) {
        const int st = i & 1;
        const int k0 = tile_of(i) * 64;
        const LAS unsigned char* sb = lds + st * STAGE;
        bf16x8 kf[2 * ND0];
        { const LAS unsigned char* kb = sb + r32 * KP + hi * 16;
#pragma unroll
          for (int d0 = 0; d0 < ND0; ++d0) { kf[2 * d0] = *(const LAS bf16x8*)(kb + d0 * 32); kf[2 * d0 + 1] = *(const LAS bf16x8*)(kb + 32 * KP + d0 * 32); } }
        SBAR();
        f32x16 p0 = negm, p1 = negm;
#pragma unroll
        for (int d0 = 0; d0 < ND0; ++d0) { p0 = __builtin_amdgcn_mfma_f32_32x32x16_bf16(kf[2 * d0], qf[d0], p0, 0, 0, 0); p1 = __builtin_amdgcn_mfma_f32_32x32x16_bf16(kf[2 * d0 + 1], qf[d0], p1, 0, 0, 0); }
        SBAR();
        bf16x8 vf[8];
        { const LAS unsigned char* vb = sb + KSUB + r32 * ATT_VP + hi * 16;
#pragma unroll
          for (int d0 = 0; d0 < 2; ++d0)
#pragma unroll
              for (int ks = 0; ks < 4; ++ks) vf[d0 * 4 + ks] = *(const LAS bf16x8*)(vb + d0 * 32 * ATT_VP + ks * 32); }
        if (i + 1 < a.ntiles) ATT_GLOAD(i + 1);
        SBAR();
        if (GQA) {
#pragma unroll
            for (int r = 0; r < 16; ++r) { const int ka = k0 + 16 * (r >> 3) + 8 * hi + (r & 7), kc = ka + 32; const int da = qp - ka, dc = qp - kc;
                if (!(ka < a.L && (ka < NMETA || (da <= 128 && da >= -128)))) p0[r] = -INFINITY;
                if (!(kc < a.L && (kc < NMETA || (dc <= 128 && dc >= -128)))) p1[r] = -INFINITY; }
        } else if (k0 + 64 > a.L) {
#pragma unroll
            for (int r = 0; r < 16; ++r) { const int ka = k0 + 16 * (r >> 3) + 8 * hi + (r & 7); if (ka >= a.L) p0[r] = -INFINITY; if (ka + 32 >= a.L) p1[r] = -INFINITY; }
        }
        float rm = fmaxf(p0[0], p1[0]);
#pragma unroll
        for (int r = 1; r < 16; ++r) rm = fmaxf(rm, fmaxf(p0[r], p1[r]));
        rm = fmaxf(rm, __shfl_xor(rm, 32));
        const bool first = (!GQA) && (i == 0);
        if (first || __any(rm > 8.f)) {
            const float dl = first ? rm : fmaxf(rm, 0.f);
            mref += dl;
#pragma unroll
            for (int r = 0; r < 16; ++r) { p0[r] -= dl; p1[r] -= dl; negm[r] = -mref; }
            if (!first) { const float f = __builtin_amdgcn_exp2f(-dl); lrun *= f;
#pragma unroll
                for (int r = 0; r < 16; ++r) { o[0][r] *= f; o[1][r] *= f; } }
        }
        typedef float f32x2_ __attribute__((ext_vector_type(2)));
        f32x2_ s2 = (f32x2_){0.f, 0.f};
#pragma unroll
        for (int r = 0; r < 16; ++r) { p0[r] = __builtin_amdgcn_exp2f(p0[r]); p1[r] = __builtin_amdgcn_exp2f(p1[r]); s2 += (f32x2_){p0[r], p1[r]}; }
        lrun += s2.x + s2.y;
        bf16x8 pk[4];
#define ATT_PACK(dst, P, b) do { u32x4 w_; w_.x = cvt_pk_bf16(P[b], P[b + 1]); w_.y = cvt_pk_bf16(P[b + 2], P[b + 3]); w_.z = cvt_pk_bf16(P[b + 4], P[b + 5]); w_.w = cvt_pk_bf16(P[b + 6], P[b + 7]); dst = __builtin_bit_cast(bf16x8, w_); } while (0)
        ATT_PACK(pk[0], p0, 0); ATT_PACK(pk[1], p0, 8); ATT_PACK(pk[2], p1, 0); ATT_PACK(pk[3], p1, 8);
#undef ATT_PACK
        SBAR();
#pragma unroll
        for (int ks = 0; ks < 4; ++ks) { o[0] = __builtin_amdgcn_mfma_f32_32x32x16_bf16(vf[ks], pk[ks], o[0], 0, 0, 0); o[1] = __builtin_amdgcn_mfma_f32_32x32x16_bf16(vf[4 + ks], pk[ks], o[1], 0, 0, 0); }
        SBAR();
        if (i + 1 < a.ntiles) ATT_LSTORE(st ^ 1);
        __syncthreads();
    }
#undef SBAR
#undef ATT_GLOAD
#undef ATT_LSTORE
    const float ltot = lrun + __shfl_xor(lrun, 32), inv = 1.f / ltot;
    if (r32 < a.nvalid) {
        bf16_t* op = a.O + (size_t)r32 * 1024 + hi * 4;
#pragma unroll
        for (int d0 = 0; d0 < 2; ++d0)
#pragma unroll
            for (int rg = 0; rg < 4; ++rg) { f32x4 v = (f32x4){o[d0][4 * rg], o[d0][4 * rg + 1], o[d0][4 * rg + 2], o[d0][4 * rg + 3]} * inv; pg8::st_bf16x4(op + d0 * 32 + rg * 8, v); }
    }
}

struct Params {
    const float* in[18]; float* out; unsigned char* ws;
    double invA[16]; double invB[8];
    int ph_lo, ph_hi;
};
constexpr int NPHASE = 16;
constexpr int LDS_BYTES = 147456;

__device__ __forceinline__ void transpose_item(const float* W, int K, int N, bf16_t* WT, int k0, int n0, int dst_n0, const float* gk, LAS float* scr, int lane) {
#pragma unroll 8
    for (int i = 0; i < 32; ++i) { const int kk = 2 * i + (lane >> 5); float v = ldg<float>(W + (size_t)(k0 + kk) * N + n0 + (lane & 31)); if (gk) v *= ldg<float>(gk + k0 + kk); scr[kk * 33 + (lane & 31)] = v; }
    asm volatile("s_waitcnt lgkmcnt(0)" ::: "memory");
    const int c = lane & 7;
#pragma unroll
    for (int j = 0; j < 4; ++j) { const int n = (lane >> 3) + 8 * j; const LAS float* s = scr + (8 * c) * 33 + n;
        u32x4 o; o.x = cvt_pk_bf16(s[0 * 33], s[1 * 33]); o.y = cvt_pk_bf16(s[2 * 33], s[3 * 33]); o.z = cvt_pk_bf16(s[4 * 33], s[5 * 33]); o.w = cvt_pk_bf16(s[6 * 33], s[7 * 33]);
        stg<u32x4>(WT + (size_t)(dst_n0 + n) * K + k0 + 8 * c, o); }
    asm volatile("s_waitcnt lgkmcnt(0)" ::: "memory");
}


#define XB_TMO      128
#define XB_XCNT(j)  (256  + 64 * (j))
#define XB_XSUB(j)  (1280 + 64 * (j))
#define XB_XGEN(j)  (2304 + 64 * (j))
#define XB_TOP      3328
#define XB_TOPGEN   3392
#define XCD_BAR_WORDS 3456
#define XB_SPIN_CAP (1u << 22)
__device__ __forceinline__ unsigned xb_ld(unsigned* p)              { return __hip_atomic_load(p, __ATOMIC_RELAXED, __HIP_MEMORY_SCOPE_AGENT); }
__device__ __forceinline__ unsigned xb_add(unsigned* p, unsigned v) { return __hip_atomic_fetch_add(p, v, __ATOMIC_RELAXED, __HIP_MEMORY_SCOPE_AGENT); }
__device__ __forceinline__ unsigned xb_xcc_id() { return (unsigned)__builtin_amdgcn_s_getreg((3 << 11) | 20) & 0xFu; }
#define XB_SPIN(cond, bar) do { unsigned _sp = 0; while (cond) { __builtin_amdgcn_s_sleep(1); \
    if ((++_sp & 255u) == 0u) { if (xb_ld(&(bar)[XB_TMO])) break; if (_sp > XB_SPIN_CAP) { atomicAdd(&(bar)[XB_TMO], 1u); break; } } } } while (0)
struct XcdBarrier { unsigned* bar; unsigned x; volatile LAS unsigned* st; };
__device__ __forceinline__ XcdBarrier xcd_barrier_post(unsigned* bar, volatile LAS unsigned* st) {
    XcdBarrier b; b.bar = bar; b.x = xb_xcc_id(); b.st = st;
    if (threadIdx.x == 0) (void)xb_add(&bar[XB_XCNT(b.x)], 1u);
    return b;
}
__device__ __forceinline__ void xcd_barrier_complete(unsigned* bar, unsigned x, unsigned& nloc, unsigned& nx) {
    const unsigned G = gridDim.x * gridDim.y * gridDim.z;
    unsigned sum, cnt, mine, sp = 0u;
    for (;;) {
        sum = 0u; cnt = 0u; mine = 0u;
#pragma unroll
        for (unsigned j = 0; j < 16; ++j) { const unsigned c = xb_ld(&bar[XB_XCNT(j)]); sum += c; cnt += (c > 0u) ? 1u : 0u; mine = (j == x) ? c : mine; }
        if (sum == G) break;
        __builtin_amdgcn_s_sleep(1);
        if ((++sp & 255u) == 0u) { if (xb_ld(&bar[XB_TMO])) break; if (sp > XB_SPIN_CAP) { atomicAdd(&bar[XB_TMO], 1u); break; } }
    }
    nloc = mine > 0u ? mine : 1u; nx = cnt > 0u ? cnt : 1u;
}
__device__ __forceinline__ void xcd_barrier(const XcdBarrier& b) {
    asm volatile("s_waitcnt vmcnt(0)" ::: "memory");
    __syncthreads();
    if (threadIdx.x == 0) {
        unsigned* bar = b.bar;
        __builtin_amdgcn_s_waitcnt(0);
        unsigned nloc = b.st[0], nx = b.st[1];
        if (nloc == 0u) { xcd_barrier_complete(bar, b.x, nloc, nx); b.st[0] = nloc; b.st[1] = nx; }
        const unsigned old = xb_add(&bar[XB_XSUB(b.x)], 1u);
        const unsigned gen = old / nloc;
        if (old + 1u == (gen + 1u) * nloc) {
            __builtin_amdgcn_fence(__ATOMIC_RELEASE, "agent");
            asm volatile("s_waitcnt vmcnt(0)" ::: "memory");
            const unsigned og = xb_add(&bar[XB_TOP], 1u);
            const unsigned tg = og / nx;
            if (og + 1u == (tg + 1u) * nx) xb_add(&bar[XB_TOPGEN], 1u);
            else XB_SPIN(xb_ld(&bar[XB_TOPGEN]) == tg, bar);
            __builtin_amdgcn_fence(__ATOMIC_ACQUIRE, "agent");
            xb_add(&bar[XB_XGEN(b.x)], 1u);
            asm volatile("s_waitcnt vmcnt(0)" ::: "memory");
        } else {
            XB_SPIN(xb_ld(&bar[XB_XGEN(b.x)]) == gen, bar);
            __builtin_amdgcn_fence(__ATOMIC_ACQUIRE, "agent");
            asm volatile("s_waitcnt vmcnt(0)" ::: "memory");
        }
    }
    __syncthreads();
}

__device__ __forceinline__ void ln_row(const bf16_t* prow, const float* g, const float* b, bf16_t* ho, float* fo, int lane) {
    float v[16]; float s = 0.f;
#pragma unroll
    for (int j = 0; j < 2; ++j) { const u32x4 w = ldg<u32x4>(prow + 8 * (lane + 64 * j));
#pragma unroll
        for (int e = 0; e < 4; ++e) { v[8 * j + 2 * e] = __uint_as_float(w[e] << 16); v[8 * j + 2 * e + 1] = __uint_as_float(w[e] & 0xffff0000u); } }
#pragma unroll
    for (int e = 0; e < 16; ++e) s += v[e];
    const float mean = wave_sum(s) * (1.f / DM); float s2 = 0.f;
#pragma unroll
    for (int e = 0; e < 16; ++e) { v[e] -= mean; s2 += v[e] * v[e]; }
    const float rstd = 1.f / sqrtf(wave_sum(s2) * (1.f / DM) + LN_EPS);
#pragma unroll
    for (int j = 0; j < 2; ++j) { const int c = 8 * (lane + 64 * j);
        const f32x4 g0 = ldg<f32x4>(g + c), g1 = ldg<f32x4>(g + c + 4), b0 = ldg<f32x4>(b + c), b1 = ldg<f32x4>(b + c + 4);
        const f32x4 y0 = (f32x4){v[8 * j], v[8 * j + 1], v[8 * j + 2], v[8 * j + 3]} * rstd * g0 + b0, y1 = (f32x4){v[8 * j + 4], v[8 * j + 5], v[8 * j + 6], v[8 * j + 7]} * rstd * g1 + b1;
        if (fo) { stg<f32x4>(fo + c, y0); stg<f32x4>(fo + c + 4, y1); }
        else { u32x4 w; w.x = cvt_pk_bf16(y0[0], y0[1]); w.y = cvt_pk_bf16(y0[2], y0[3]); w.z = cvt_pk_bf16(y1[0], y1[1]); w.w = cvt_pk_bf16(y1[2], y1[3]); stg<u32x4>(ho + c, w); } }
}

__global__ void __launch_bounds__(512, 2) mega(Params p) {
    __builtin_assume(__builtin_amdgcn_workitem_id_y() == 0); __builtin_assume(__builtin_amdgcn_workitem_id_z() == 0);
    extern __shared__ __attribute__((aligned(16))) unsigned char lds_raw[];
    LAS unsigned char* lds = (LAS unsigned char*)lds_raw;
    const int tid = threadIdx.x, lane = tid & 63, wave = __builtin_amdgcn_readfirstlane(tid >> 6);
    const int G = gridDim.x, bid = blockIdx.x;
    const int gw = bid * 8 + wave, NGW = G * 8;
    unsigned char* ws = p.ws; unsigned char* ob = (unsigned char*)p.out;
#define ropeA ((float*)(ws + WS_ROPEA))
#define ropeB ((float*)(ws + WS_ROPEB))
#define rsv ((float*)(ws + WS_RS))
#define PRE ((bf16_t*)(ws + WS_X))
#define Hb ((bf16_t*)(ob + O_H))
#define VT ((bf16_t*)(ws + WS_VT))
#define KR ((bf16_t*)(ob + O_KR))
#define Cb ((bf16_t*)(ws + B_C))
#define ATT ((bf16_t*)(ws + B_ATT))
#define Qb ((bf16_t*)(ws + B_Q))
#define KN ((bf16_t*)(ws + B_KN))
#define VT2 ((bf16_t*)(ws + B_VT2))
#define Ub ((bf16_t*)(ws + B_U))
#define Win ((bf16_t*)(ws + W_IN))
#define Wuq ((bf16_t*)(ws + W_UQ))
#define Wukv ((bf16_t*)(ws + W_UKV))
#define Wo0 ((bf16_t*)(ws + W_O0))
#define Wqkv ((bf16_t*)(ws + W_QKV))
#define Wo1 ((bf16_t*)(ws + W_O1))
#define W1 ((bf16_t*)(ws + W_1))
#define W2 ((bf16_t*)(ws + W_2))
    const float* x_prompt = p.in[0]; const float* x_sample = p.in[1]; const float* meta = p.in[2];
    const float* ln1_g = p.in[14]; const float* ln1_b = p.in[15]; const float* ln2_g = p.in[16]; const float* ln2_b = p.in[17];
    cg::grid_group grid = cg::this_grid();
    volatile LAS unsigned* bst = (volatile LAS unsigned*)(lds + 131072 + 64);
    if (tid < 2) bst[tid] = 0u;
    __syncthreads();
    XcdBarrier xbar; xbar.bar = (unsigned*)p.ws; xbar.x = 0; xbar.st = bst;
    if (p.ph_hi - p.ph_lo > 1) xbar = xcd_barrier_post((unsigned*)p.ws, bst);
    const int lo = p.ph_lo, hi_ph = p.ph_hi;
#ifndef PHMASK
#define PHMASK 0x1ffff
#endif
#define IN(k) (((PHMASK >> (k)) & 1) && lo <= (k) && (k) < hi_ph)
#define SEAM(k) do { if (IN(k) && IN((k) + 1)) { if ((k) == 0) grid.sync(); else xcd_barrier(xbar); } asm volatile("" : "+s"(ws), "+s"(ob)); } while (0)
#define GEMM(EPI, Aptr, LDA, Bptr, NN, KK, ...) do { pg8::Gemm g_{Aptr, Bptr, TP, NN, KK, LDA}; pg8::StaticOrder S_; S_.init(TP, NN, G, bid); pg8::EPI E_{__VA_ARGS__}; pg8::gemm_phase<pg8::EPI>(lds, g_, S_, E_); } while (0)

    if (IN(0)) {
        LAS float* scr = (LAS float*)(lds + wave * 16384);
        for (int it = gw; it < 11344; it += NGW) {
            int mi, r = it, nbv;
            if (r < 528) { mi = 0; nbv = 33; } else if ((r -= 528) < 576) { mi = 1; nbv = 48; } else if ((r -= 576) < 256) { mi = 2; nbv = 64; } else if ((r -= 256) < 512) { mi = 3; nbv = 32; }
            else if ((r -= 512) < 768) { mi = 4; nbv = 48; } else if ((r -= 768) < 512) { mi = 5; nbv = 32; } else if ((r -= 512) < 2048) { mi = 6; nbv = 128; } else if ((r -= 2048) < 2048) { mi = 7; nbv = 128; }
            else if ((r -= 2048) < 2048) { mi = 8; nbv = 32; } else { r -= 2048; mi = 9; nbv = 32; }
            const int kbi = r / nbv, nbi = r % nbv, k0 = 64 * kbi, n0 = 32 * nbi;
            if (mi == 0) transpose_item(p.in[3], 1024, NC, Win, k0, n0, n0, nullptr, scr, lane);
            else if (mi == 1) transpose_item(p.in[5], 768, 1536, Wuq, k0, n0, n0, p.in[4], scr, lane);
            else if (mi == 2) { const int head = n0 >> 7, part = (n0 >> 6) & 1, d0 = n0 & 63; transpose_item(p.in[7], 256, 2048, Wukv, k0, n0, part * 1024 + head * 64 + d0, p.in[6], scr, lane); }
            else if (mi == 3) transpose_item(p.in[8], 1024, 1024, Wo0, k0, n0, n0, nullptr, scr, lane);
            else if (mi == 4) transpose_item(p.in[9], 1024, 1536, Wqkv, k0, n0, n0, nullptr, scr, lane);
            else if (mi == 5) transpose_item(p.in[11], 1024, 1024, Wo1, k0, n0, n0, nullptr, scr, lane);
            else if (mi == 6) transpose_item(p.in[12], 1024, 4096, W1, k0, n0, n0, nullptr, scr, lane);
            else if (mi == 7) transpose_item(p.in[12] + (size_t)1024 * 4096, 1024, 4096, W1 + (size_t)4096 * 1024, k0, n0, n0, nullptr, scr, lane);
            else if (mi == 8) transpose_item(p.in[13], 4096, 1024, W2, k0, n0, n0, nullptr, scr, lane);
            else transpose_item(p.in[13] + (size_t)4096 * 1024, 4096, 1024, W2 + (size_t)1024 * 4096, k0, n0, n0, nullptr, scr, lane);
        }
        for (int r = 1056 + gw; r < 1280; r += NGW) { u32x4* d = (u32x4*)(Win + (size_t)r * 1024); d[lane] = (u32x4){0, 0, 0, 0}; d[lane + 64] = (u32x4){0, 0, 0, 0}; }
        for (int t = gw; t < TP; t += NGW) {
            bf16_t* ho = Hb + (size_t)t * DM;
            if (t < T_ALL) { int seq, pos; tok2sp(t, seq, pos);
                const float* src = pos < NMETA ? meta + (size_t)pos * DM : (seq < NSEQ_P ? x_prompt + ((size_t)seq * 2048 + pos - NMETA) * DM : x_sample + ((size_t)(seq - NSEQ_P) * 4096 + pos - NMETA) * DM);
#pragma unroll
                for (int j = 0; j < 4; ++j) { const f32x4 v = ldg<f32x4>((const f32x4*)src + lane + 64 * j); pg8::st_bf16x4(ho + (size_t)(lane + 64 * j) * 4, v); }
            } else {
#pragma unroll
                for (int j = 0; j < 4; ++j) stg<u32x2>(ho + (size_t)(lane + 64 * j) * 4, (u32x2){0, 0});
            }
        }
        for (int e = bid * 512 + tid; e < 4112 * 24; e += G * 512) {
            const int pos = e / 24, i = e % 24; const double inv = i < 16 ? p.invA[i] : p.invB[i - 16];
            double rev = (double)pos * inv * 0.15915494309189535; rev -= floor(rev);
            const float fr_ = (float)rev; const float s = __builtin_amdgcn_sinf(fr_), c = __builtin_amdgcn_cosf(fr_);
            if (i < 16) { ropeA[pos * 32 + i] = c; ropeA[pos * 32 + 16 + i] = s; } else { ropeB[pos * 16 + i - 16] = c; ropeB[pos * 16 + 8 + i - 16] = s; }
        }
    }
    SEAM(0);
    if (IN(1)) GEMM(EpiStore, Hb, 1024, Win, 1280, 1024, Cb, NC, NC);
    SEAM(1);
    if (IN(2)) {
        for (int t = gw; t < TP; t += NGW) {
            const bf16_t* cr = Cb + (size_t)t * NC; float sq = 0.f, skv = 0.f;
#pragma unroll
            for (int j = 0; j < 3; ++j) { const u32x2 w = *(const u32x2*)(cr + lane * 12 + j * 4);
                const float a = __uint_as_float(w.x << 16), b = __uint_as_float(w.x & 0xffff0000u), c = __uint_as_float(w.y << 16), d = __uint_as_float(w.y & 0xffff0000u); sq += (a * a + b * b) + (c * c + d * d); }
            { const u32x2 w = *(const u32x2*)(cr + 768 + lane * 4);
                const float a = __uint_as_float(w.x << 16), b = __uint_as_float(w.x & 0xffff0000u), c = __uint_as_float(w.y << 16), d = __uint_as_float(w.y & 0xffff0000u); skv = (a * a + b * b) + (c * c + d * d); }
            sq = wave_sum(sq); skv = wave_sum(skv);
            if (lane == 0) { rsv[2 * t] = C2_MLA / sqrtf(sq * (1.f / 768.f) + RMS_EPS); rsv[2 * t + 1] = 1.f / sqrtf(skv * (1.f / 256.f) + RMS_EPS); }
            if (lane < 16) { int seq, pos; tok2sp(t, seq, pos);
                const float x1 = bf2f(cr[1024 + lane]), x2 = bf2f(cr[1040 + lane]), c = ropeA[pos * 32 + lane], s = ropeA[pos * 32 + 16 + lane];
                const unsigned w = cvt_pk_bf16(x1 * c - x2 * s, x2 * c + x1 * s);
                KR[(size_t)t * 32 + lane] = (bf16_t)(w & 0xffffu); KR[(size_t)t * 32 + 16 + lane] = (bf16_t)(w >> 16); }
        }
    }
    SEAM(2);
    if (IN(3)) {
#ifndef SK1
        GEMM(EpiQ, Cb, NC, Wuq, 1536, 768, Qb, rsv, ropeA);
#endif
#ifndef SK2
        GEMM(EpiScale, Cb + 768, NC, Wukv, 1024, 256, KN, 1024, rsv);
#endif
#ifndef SK3
        GEMM(EpiVt, Cb + 768, NC, Wukv + (size_t)1024 * 256, 1024, 256, VT, rsv, 16);
#endif
    }
    SEAM(3);
    if (IN(4)) {
        constexpr int NU_S = NSEQ_S * 16 * 17, NU_P = NSEQ_P * 16 * 9;
        const int vcu = (G % 8 == 0) ? (bid % 8) * (G / 8) + bid / 8 : bid;
        for (int un = vcu; un < NU_S + NU_P; un += G) {
            int seq, head, qb, L, tb, lp;
            if (un < NU_S) { seq = NSEQ_P + un / 272; const int r = un % 272; head = r / 17; qb = r % 17; L = L_S; tb = T_P + (seq - NSEQ_P) * L_S; lp = LPAD_S; }
            else { const int v = un - NU_S; seq = v / 144; const int r = v % 144; head = r / 9; qb = r % 9; L = L_P; tb = seq * L_P; lp = LPAD_P; }
            const int q0 = qb * 256 + wave * 32;
            AttnUnit a;
            a.Q = Qb + (size_t)(tb + q0) * 1536 + head * 96; a.ldq = 1536;
            a.Kn = KN + (size_t)tb * 1024 + head * 64; a.ldk = 1024; a.Kr = KR + (size_t)tb * 32;
            a.Vt = VT + vt_off(seq, head, 16); a.lpad = lp;
            a.O = ATT + (size_t)(tb + q0) * 1024 + head * 64;
            a.L = L; a.nvalid = L - q0; a.meta_first = 0; a.t_lo = 0; a.ntiles = (L + 63) / 64; a.qpos0 = q0; a.m0 = 0.f; a.l0 = 0.f;
            attn_unit<96, false>(lds, a);
        }
    }
    SEAM(4);
    if (IN(5)) GEMM(EpiRes, ATT, 1024, Wo0, 1024, 1024, Hb, PRE);
    SEAM(5);
    if (IN(6)) for (int t = gw; t < TP; t += NGW) ln_row(PRE + (size_t)t * DM, ln1_g, ln1_b, Hb + (size_t)t * DM, nullptr, lane);
    SEAM(6);
    if (IN(7)) GEMM(EpiRelu2, Hb, 1024, W1, 4096, 1024, Ub, DFF);
    SEAM(7);
    if (IN(8)) GEMM(EpiRes, Ub, DFF, W2, 1024, 4096, Hb, PRE);
    SEAM(8);
    if (IN(9)) {
        for (int t = gw; t < TP; t += NGW) ln_row(PRE + (size_t)t * DM, ln2_g, ln2_b, Hb + (size_t)t * DM, nullptr, lane);
    }
    SEAM(9);
    if (IN(10)) {
        GEMM(EpiQK2, Hb, 1024, Wqkv, 1280, 1024, Qb, ropeB);
        GEMM(EpiVt, Hb, 1024, Wqkv + (size_t)1280 * 1024, 256, 1024, VT2, nullptr, 4);
    }
    SEAM(10);
    if (IN(11)) {
        constexpr int NU_S = NSEQ_S * 4 * 65, NU_P = NSEQ_P * 4 * 33;
        const float* sink = p.in[10];
        const int vcu = (G % 8 == 0) ? (bid % 8) * (G / 8) + bid / 8 : bid;
        for (int un = vcu; un < NU_S + NU_P; un += G) {
            int seq, kvh, qb, L, tb, lp;
            if (un < NU_S) { seq = NSEQ_P + un / 260; const int r = un % 260; kvh = r / 65; qb = r % 65; L = L_S; tb = T_P + (seq - NSEQ_P) * L_S; lp = LPAD_S; }
            else { const int v = un - NU_S; seq = v / 132; const int r = v % 132; kvh = r / 33; qb = r % 33; L = L_P; tb = seq * L_P; lp = LPAD_P; }
            const int hq = kvh * 4 + (wave >> 1), q0 = qb * 64 + (wave & 1) * 32, NT = (L + 63) / 64;
            AttnUnit a;
            a.Q = Qb + (size_t)(tb + q0) * 1280 + hq * 64; a.ldq = 1280;
            a.Kn = Qb + (size_t)tb * 1280 + 1024 + kvh * 64; a.ldk = 1280; a.Kr = nullptr;
            a.Vt = VT2 + vt_off(seq, kvh, 4); a.lpad = lp;
            a.O = ATT + (size_t)(tb + q0) * 1024 + hq * 64;
            a.L = L; a.nvalid = L - q0;
            const int tlo = qb - 2 > 0 ? qb - 2 : 0, thi = qb + 2 < NT - 1 ? qb + 2 : NT - 1;
            a.meta_first = tlo > 0 ? 1 : 0; a.t_lo = tlo; a.ntiles = (thi - tlo + 1) + a.meta_first; a.qpos0 = q0;
            a.m0 = sink[hq] * LOG2E; a.l0 = 1.f;
            attn_unit<64, true>(lds, a);
        }
    }
    SEAM(11);
    if (IN(12)) GEMM(EpiRes, ATT, 1024, Wo1, 1024, 1024, Hb, PRE);
    SEAM(12);
    if (IN(13)) for (int t = gw; t < TP; t += NGW) ln_row(PRE + (size_t)t * DM, ln1_g + DM, ln1_b + DM, Hb + (size_t)t * DM, nullptr, lane);
    SEAM(13);
    if (IN(14)) GEMM(EpiRelu2, Hb, 1024, W1 + (size_t)4096 * 1024, 4096, 1024, Ub, DFF);
    SEAM(14);
    if (IN(15)) GEMM(EpiRes, Ub, DFF, W2 + (size_t)1024 * 4096, 1024, 4096, Hb, PRE);
    SEAM(15);
    if (IN(16)) for (int t = gw; t < T_ALL; t += NGW) { int seq, pos; tok2sp(t, seq, pos); if (pos < NMETA) continue;
        const size_t orow = seq < NSEQ_P ? (size_t)seq * 2048 + pos - NMETA : (size_t)NSEQ_P * 2048 + (size_t)(seq - NSEQ_P) * 4096 + pos - NMETA;
        ln_row(PRE + (size_t)t * DM, ln2_g + DM, ln2_b + DM, nullptr, p.out + orow * DM, lane); }
#undef IN
#undef SEAM
#undef GEMM
}

extern "C" void kernel_launch(void* const* d_in, const int* in_sizes, int n_in, void* d_out, int out_size, void* d_ws, size_t ws_size, hipStream_t stream) {
    static int grid = 0;
    if (grid == 0) {
        if (n_in != 18 || ws_size < WS_NEED || (size_t)out_size < (size_t)81920 * 1024) { fprintf(stderr, "kernel_launch: unexpected problem (n_in %d, ws %zu, out %d)\n", n_in, ws_size, out_size); grid = -1; return; }
        int dev = 0, cus = 0, per_cu = 0;
        hipGetDevice(&dev); hipDeviceGetAttribute(&cus, hipDeviceAttributeMultiprocessorCount, dev);
        hipFuncSetAttribute((const void*)mega, hipFuncAttributeMaxDynamicSharedMemorySize, LDS_BYTES);
        hipOccupancyMaxActiveBlocksPerMultiprocessor(&per_cu, (const void*)mega, 512, LDS_BYTES);
        (void)hipGetLastError();
        if (per_cu < 1) per_cu = 1;
        grid = cus * per_cu;
    }
    if (grid < 0) return;
    if (hipMemsetAsync(d_ws, 0, 16384, stream) != hipSuccess) { fprintf(stderr, "kernel_launch: memset failed\n"); return; }
    Params p{};
    for (int i = 0; i < 18; ++i) p.in[i] = (const float*)d_in[i];
    p.out = (float*)d_out; p.ws = (unsigned char*)d_ws;
    for (int i = 0; i < 16; ++i) p.invA[i] = std::pow(500000.0, -(double)(2 * i) / 32.0);
    for (int i = 0; i < 8; ++i) p.invB[i] = std::pow(500000.0, -(double)(2 * i) / 16.0);
#if MK_PER_PHASE
    for (int ph = 0; ph <= NPHASE; ++ph) { p.ph_lo = ph; p.ph_hi = ph + 1; hipLaunchKernelGGL(mega, dim3(grid), dim3(512), LDS_BYTES, stream, p); }
#else
    p.ph_lo = 0; p.ph_hi = NPHASE + 1;
    void* args[] = {&p};
    hipError_t e = hipLaunchCooperativeKernel((const void*)mega, dim3(grid), dim3(512), args, LDS_BYTES, stream);
    if (e != hipSuccess) fprintf(stderr, "cooperative launch failed: %s (grid %d)\n", hipGetErrorString(e), grid);
#endif
}
```
